# Optimizing an MI355X kernel written in HIP

```python
import math
import jax, jax.numpy as jnp
from jax import lax
import numpy as np

D_MODEL = 2048
BATCH = 2
SEQ = 8192
DEPTH = 2

MIX_WIDTH = D_MODEL
ATT_WIDTH = MIX_WIDTH // 2
REC_WIDTH = MIX_WIDTH - ATT_WIDTH
ATT_HEAD_DIM = 64
ATT_V_DIM = 2 * ATT_HEAD_DIM
ATT_HEADS = ATT_WIDTH // ATT_V_DIM
REC_EXPAND = 128
REC_HEADS = REC_WIDTH // REC_EXPAND
REC_K_DIM = REC_EXPAND
REC_V_DIM = REC_WIDTH // REC_HEADS
D_FF = 5504
ROPE_THETA = 10000.0
NORM_EPS = 1e-6
Q_BLOCK = 128
CHUNK = 64

IN_SIZES = (
    ATT_HEADS * 2 * ATT_HEAD_DIM,
    ATT_HEADS * 2 * ATT_HEAD_DIM,
    ATT_HEADS * ATT_V_DIM,
    REC_HEADS * REC_K_DIM,
    REC_HEADS * REC_K_DIM,
    REC_HEADS * REC_V_DIM,
    REC_HEADS * REC_V_DIM,
)
IN_COLS = sum(IN_SIZES)
IN_SPLITS = tuple(int(v) for v in np.cumsum(IN_SIZES)[:-1])

kernel_name = "hybrid_diffattn_hgrn2_macaron"


def rmsnorm(x, w):
    xf = x.astype(jnp.float32)
    y = xf * lax.rsqrt(jnp.mean(xf * xf, axis=-1, keepdims=True) + NORM_EPS)
    return (y * w.astype(jnp.float32)).astype(x.dtype)


def swiglu(h, w_gate, w_up, w_down):
    return (jax.nn.silu(h @ w_gate) * (h @ w_up)) @ w_down


def rope(t, pos):
    d = t.shape[-1]
    inv_freq = ROPE_THETA ** (-jnp.arange(0, d, 2, dtype=jnp.float32) / d)
    ang = pos[:, None] * inv_freq[None, :]
    ang = jnp.concatenate([ang, ang], axis=-1)[None, :, None, :]
    tf = t.astype(jnp.float32)
    t1, t2 = jnp.split(tf, 2, axis=-1)
    rot = jnp.concatenate([-t2, t1], axis=-1)
    return (tf * jnp.cos(ang) + rot * jnp.sin(ang)).astype(t.dtype)


def diff_attention(q, k, v, lam, lambda_init, subln_w):
    B, S, H = q.shape[0], q.shape[1], q.shape[2]
    q = q.transpose(0, 3, 2, 1, 4)
    k = k.transpose(0, 3, 2, 1, 4)
    vt = v.transpose(0, 2, 1, 3)
    scale = ATT_HEAD_DIM ** -0.5
    kpos = jnp.arange(S)

    def one_block(blk):
        start = blk * Q_BLOCK
        qb = lax.dynamic_slice_in_dim(q, start, Q_BLOCK, axis=3)
        s = jnp.einsum('bchqd,bchkd->bchqk', qb, k,
                       preferred_element_type=jnp.float32) * scale
        qpos = start + jnp.arange(Q_BLOCK)
        mask = kpos[None, :] <= qpos[:, None]
        p = jax.nn.softmax(jnp.where(mask, s, -jnp.inf), axis=-1)
        a = p[:, 0] - lam * p[:, 1]
        return jnp.einsum('bhqk,bhkd->bhqd', a.astype(vt.dtype), vt)

    out = lax.map(one_block, jnp.arange(S // Q_BLOCK))
    out = out.transpose(1, 0, 3, 2, 4).reshape(B, S, H, ATT_V_DIM)
    out = rmsnorm(out, subln_w) * (1.0 - lambda_init)
    return out.reshape(B, S, H * ATT_V_DIM)


def hgrn2(q, f_logit, i, g, lb, gnorm_w):
    B, S, H, K = q.shape
    V = i.shape[-1]
    n_chunks = S // CHUNK
    qf = jax.nn.silu(q.astype(jnp.float32))
    fl = f_logit.astype(jnp.float32)
    lb = lb.astype(jnp.float32)
    log_f = jnp.log(lb + (1.0 - lb) * jax.nn.sigmoid(fl))
    kk = (1.0 - lb) * jax.nn.sigmoid(-fl)
    vv = i.astype(jnp.float32)

    def to_chunks(t):
        return t.reshape(B, n_chunks, CHUNK, H, t.shape[-1]).transpose(1, 0, 3, 2, 4)

    tri = jnp.tril(jnp.ones((CHUNK, CHUNK), dtype=bool))[:, :, None]

    def step(state, inp):
        qc, kc, vc, lfc = inp
        b = jnp.cumsum(lfc, axis=2)
        o_inter = jnp.einsum('bhtk,bhkv->bhtv', qc * jnp.exp(b), state)
        rel = b[:, :, :, None, :] - b[:, :, None, :, :]
        decay = jnp.where(tri, jnp.exp(jnp.where(tri, rel, 0.0)), 0.0)
        scores = jnp.einsum('bhtsk,bhsk->bhts', qc[:, :, :, None, :] * decay, kc)
        o_intra = jnp.einsum('bhts,bhsv->bhtv', scores, vc)
        b_last = b[:, :, -1:, :]
        new_state = (jnp.exp(b_last[:, :, 0, :])[..., None] * state
                     + jnp.einsum('bhsk,bhsv->bhkv', kc * jnp.exp(b_last - b), vc))
        return new_state, o_inter + o_intra

    state0 = jnp.zeros((B, H, K, V), jnp.float32)
    _, o = lax.scan(step, state0, (to_chunks(qf), to_chunks(kk), to_chunks(vv), to_chunks(log_f)))
    o = o.transpose(1, 0, 3, 2, 4).reshape(B, S, H, V)
    o = rmsnorm(o, gnorm_w).reshape(B, S, H * V)
    o = o * jax.nn.silu(g.astype(jnp.float32))
    return o.astype(g.dtype)


def setup_inputs(seed: int = 0) -> dict:
    key = jax.random.key(seed)
    ks = jax.random.split(key, 24)
    f32 = jnp.float32

    def nrm(k, shape, scale):
        return jax.random.normal(k, shape, f32) * scale

    def gain(k, shape):
        return 1.0 + 0.01 * jax.random.normal(k, shape, f32)

    return {
        "x": jax.random.normal(ks[0], (BATCH, SEQ, D_MODEL), f32),
        "ffn1_norm": gain(ks[1], (DEPTH, D_MODEL)),
        "ffn1_w_gate": nrm(ks[2], (DEPTH, D_MODEL, D_FF), D_MODEL ** -0.5),
        "ffn1_w_up": nrm(ks[3], (DEPTH, D_MODEL, D_FF), D_MODEL ** -0.5),
        "ffn1_w_down": nrm(ks[4], (DEPTH, D_FF, D_MODEL), D_FF ** -0.5),
        "mix_norm": gain(ks[5], (DEPTH, D_MODEL)),
        "w_in": nrm(ks[6], (DEPTH, D_MODEL, IN_COLS), D_MODEL ** -0.5),
        "w_out": nrm(ks[7], (DEPTH, MIX_WIDTH, D_MODEL), MIX_WIDTH ** -0.5),
        "lambda_q1": nrm(ks[8], (DEPTH, ATT_HEAD_DIM), 0.1),
        "lambda_k1": nrm(ks[9], (DEPTH, ATT_HEAD_DIM), 0.1),
        "lambda_q2": nrm(ks[10], (DEPTH, ATT_HEAD_DIM), 0.1),
        "lambda_k2": nrm(ks[11], (DEPTH, ATT_HEAD_DIM), 0.1),
        "diff_subln": gain(ks[12], (DEPTH, ATT_V_DIM)),
        "hgrn_lower_bounds": nrm(ks[13], (DEPTH, REC_HEADS * REC_K_DIM), 0.1),
        "hgrn_gnorm": gain(ks[14], (DEPTH, REC_V_DIM)),
        "ffn2_norm": gain(ks[15], (DEPTH, D_MODEL)),
        "ffn2_w_gate": nrm(ks[16], (DEPTH, D_MODEL, D_FF), D_MODEL ** -0.5),
        "ffn2_w_up": nrm(ks[17], (DEPTH, D_MODEL, D_FF), D_MODEL ** -0.5),
        "ffn2_w_down": nrm(ks[18], (DEPTH, D_FF, D_MODEL), D_FF ** -0.5),
        "final_norm": gain(ks[19], (D_MODEL,)),
    }


def reference(x, ffn1_norm, ffn1_w_gate, ffn1_w_up, ffn1_w_down, mix_norm, w_in, w_out,
              lambda_q1, lambda_k1, lambda_q2, lambda_k2, diff_subln, hgrn_lower_bounds,
              hgrn_gnorm, ffn2_norm, ffn2_w_gate, ffn2_w_up, ffn2_w_down, final_norm):
    B, S, _ = x.shape
    pos = jnp.arange(S, dtype=jnp.float32)
    lbs = jax.nn.softmax(hgrn_lower_bounds.astype(jnp.float32), axis=0)
    lbs = jnp.cumsum(lbs, axis=0) - lbs[0]

    for l in range(DEPTH):
        h = rmsnorm(x, ffn1_norm[l])
        x = x + 0.5 * swiglu(h, ffn1_w_gate[l], ffn1_w_up[l], ffn1_w_down[l])

        h = rmsnorm(x, mix_norm[l])
        proj = h @ w_in[l]
        aq, ak, av, rq, rf, ri, rg = jnp.split(proj, IN_SPLITS, axis=-1)

        aq = rope(aq.reshape(B, S, 2 * ATT_HEADS, ATT_HEAD_DIM), pos).reshape(B, S, ATT_HEADS, 2, ATT_HEAD_DIM)
        ak = rope(ak.reshape(B, S, 2 * ATT_HEADS, ATT_HEAD_DIM), pos).reshape(B, S, ATT_HEADS, 2, ATT_HEAD_DIM)
        av = av.reshape(B, S, ATT_HEADS, ATT_V_DIM)
        lambda_init = 0.8 - 0.6 * math.exp(-0.3 * l)
        lam = (jnp.exp(jnp.sum(lambda_q1[l].astype(jnp.float32) * lambda_k1[l].astype(jnp.float32)))
               - jnp.exp(jnp.sum(lambda_q2[l].astype(jnp.float32) * lambda_k2[l].astype(jnp.float32)))
               + lambda_init)
        att_out = diff_attention(aq, ak, av, lam, lambda_init, diff_subln[l])

        rec_out = hgrn2(rq.reshape(B, S, REC_HEADS, REC_K_DIM),
                        rf.reshape(B, S, REC_HEADS, REC_K_DIM),
                        ri.reshape(B, S, REC_HEADS, REC_V_DIM),
                        rg,
                        lbs[l].reshape(REC_HEADS, REC_K_DIM),
                        hgrn_gnorm[l])

        mix = jnp.concatenate([att_out, rec_out.astype(att_out.dtype)], axis=-1)
        x = x + mix @ w_out[l]

        h = rmsnorm(x, ffn2_norm[l])
        x = x + 0.5 * swiglu(h, ffn2_w_gate[l], ffn2_w_up[l], ffn2_w_down[l])

    return rmsnorm(x, final_norm)
```

```cpp
#include <hip/hip_runtime.h>
#include <hip/hip_cooperative_groups.h>
#include <cstdio>
#include <cstdint>
namespace cg = cooperative_groups;


#define LAS __attribute__((address_space(3)))
typedef unsigned short bf16_t;
typedef short bf16x8 __attribute__((ext_vector_type(8)));
typedef short s16x4 __attribute__((ext_vector_type(4)));
typedef short v4i16_t __attribute__((ext_vector_type(4)));
typedef float f32x2 __attribute__((ext_vector_type(2)));
typedef float f32x4 __attribute__((ext_vector_type(4)));
typedef float f32x16 __attribute__((ext_vector_type(16)));
typedef unsigned u32x2 __attribute__((ext_vector_type(2)));
typedef unsigned u32x4 __attribute__((ext_vector_type(4)));
typedef __bf16 bf16x2_t __attribute__((ext_vector_type(2)));

constexpr int SEQ = 8192, BATCH = 2, M = BATCH * SEQ, D = 2048, FF = 5504, NGU = 2 * FF, INC = 7168, DEPTH = 2;
constexpr int COL_AQ = 0, COL_AK = 1024, COL_AV = 2048, COL_RQ = 3072, COL_RF = 4096, COL_RI = 5120, COL_RG = 6144;
constexpr float NORM_EPS = 1e-6f;
constexpr int LDS_BYTES = 147456;
constexpr int NPHASE = 1 + 12 * DEPTH;

constexpr size_t SZ_GU = (size_t)NGU * D * 2, SZ_DN = (size_t)D * FF * 2, SZ_IN = (size_t)INC * D * 2, SZ_WO = (size_t)D * D * 2;
constexpr size_t LW_GU1 = 0, LW_D1 = LW_GU1 + SZ_GU, LW_IN = LW_D1 + SZ_DN, LW_WO = LW_IN + SZ_IN, LW_GU2 = LW_WO + SZ_WO, LW_D2 = LW_GU2 + SZ_GU, LW_BYTES = LW_D2 + SZ_DN;
constexpr size_t WS_W = 0, WS_HB = WS_W + DEPTH * LW_BYTES, WS_BIG = WS_HB + (size_t)M * D * 2, WS_HST = WS_BIG + (size_t)M * INC * 2,
                 WS_HDEC = WS_HST + (size_t)2048 * 16384 * 2, WS_COS = WS_HDEC + (size_t)2048 * 128 * 4, WS_SIN = WS_COS + (size_t)SEQ * 32 * 4, WS_CTL = WS_SIN + (size_t)SEQ * 32 * 4, CTL_BYTES = 131072, WS_SLOT = WS_CTL + CTL_BYTES, WS_HB2 = WS_SLOT + (size_t)6 * M * 32 * 4, WS_END = WS_HB2 + (size_t)M * D * 2;

struct Params {
    const float* x; const float* ffn1_norm; const float* ffn1_wg; const float* ffn1_wu; const float* ffn1_wd;
    const float* mix_norm; const float* w_in; const float* w_out;
    const float* lq1; const float* lk1; const float* lq2; const float* lk2; const float* subln; const float* hlb; const float* gnorm;
    const float* ffn2_norm; const float* ffn2_wg; const float* ffn2_wu; const float* ffn2_wd; const float* final_norm;
    float* out; unsigned char* ws; int ph_lo; int ph_hi;
};

__device__ __forceinline__ unsigned f2bf(float f) { unsigned u = __builtin_bit_cast(unsigned, f); return (u + 0x7fffu + ((u >> 16) & 1u)) >> 16; }
__device__ __forceinline__ unsigned pk2(float lo, float hi) { f32x2 v = {lo, hi}; bf16x2_t b = __builtin_convertvector(v, bf16x2_t); return __builtin_bit_cast(unsigned, b); }
__device__ __forceinline__ float bf2f(bf16_t b) { return __builtin_bit_cast(float, ((unsigned)b) << 16); }
__device__ __forceinline__ float bflo(unsigned w) { return __builtin_bit_cast(float, w << 16); }
__device__ __forceinline__ float bfhi(unsigned w) { return __builtin_bit_cast(float, w & 0xffff0000u); }
__device__ __forceinline__ float wave_sum(float v) {
#pragma unroll
    for (int o = 1; o < 64; o <<= 1) v += __shfl_xor(v, o);
    return v;
}
__device__ __forceinline__ int BID() { int b = blockIdx.x; asm volatile("" : "+s"(b)); return b; }
__device__ __forceinline__ int GSZ() { int g = gridDim.x; asm volatile("" : "+s"(g)); return g; }
__device__ __forceinline__ float fexp(float x) { return __builtin_amdgcn_exp2f(x * 1.4426950408889634f); }
__device__ __forceinline__ float flog(float x) { return __builtin_amdgcn_logf(x) * 0.6931471805599453f; }
__device__ __forceinline__ float frcp(float x) { return __builtin_amdgcn_rcpf(x); }
__device__ __forceinline__ float sigmoidf_(float x) { return frcp(1.0f + fexp(-x)); }
__device__ __forceinline__ float siluf_(float x) { return x * sigmoidf_(x); }
__host__ __device__ __forceinline__ int perm32(int rho) { const int n = rho >> 4, i = rho & 15; return 8 * (i >> 2) + 4 * n + (i & 3); }
__device__ __forceinline__ float max3f(float a, float b, float c) { float r; asm("v_max3_f32 %0, %1, %2, %3" : "=v"(r) : "v"(a), "v"(b), "v"(c)); return r; }
__device__ __forceinline__ void swap16(unsigned& a, unsigned& b) { auto r = __builtin_amdgcn_permlane16_swap(a, b, false, false); a = r[0]; b = r[1]; }
__device__ __forceinline__ void swap32(unsigned& a, unsigned& b) { auto r = __builtin_amdgcn_permlane32_swap(a, b, false, false); a = r[0]; b = r[1]; }
__device__ __forceinline__ int crow(int r, int hi) { return (r & 3) + 8 * (r >> 2) + 4 * hi; }
__device__ __forceinline__ unsigned off_b(unsigned row, unsigned ch) { return 256u * row + 16u * (ch ^ (((row & 3) << 2) | ((row >> 2) & 3))); }
__device__ __forceinline__ s16x4 vtr(LAS const unsigned char* p) { return __builtin_bit_cast(s16x4, __builtin_amdgcn_ds_read_tr16_b64_v4i16((LAS v4i16_t*)p)); }
__device__ __forceinline__ bf16x8 cat8(s16x4 a, s16x4 b) { return (bf16x8){a[0], a[1], a[2], a[3], b[0], b[1], b[2], b[3]}; }

namespace pg8 {
constexpr int BM = 256, BK = 64, HALF = 128, HTB = HALF * BK * 2, STAGE_BYTES = 8 * HTB, NXCD = 8, WGM = 8;
__host__ __device__ __forceinline__ int lds_byte(int r, int c) { const int st = (r >> 4) * 2 + (c >> 5), rr = r & 15, cc = c & 31, ob = rr * 64 + cc * 2; return st * 1024 + (ob ^ (((ob >> 9) & 1) << 5)); }
__host__ __device__ __forceinline__ void stage_rc(int b, int& R, int& C) { const int st = b / 1024, sb = b % 1024, swz = sb ^ (((sb >> 9) & 1) << 5); R = (st >> 1) * 16 + swz / 64; C = (st & 1) * 32 + (swz % 64) / 2; }
struct Unit { int pm, pn; };
struct Gemm { const bf16_t* A; const bf16_t* Bt; int M, N, K; };
struct StaticOrder {
    int nM, nN, nwg, G, c;
    __device__ void init(int M_, int N_, int G_, int c_) { nM = M_ / BM; nN = N_ / BM; nwg = nM * nN; G = G_; c = c_; }
    __device__ bool next(int i, Unit& u) const {
        const long L = (long)i * G + c; if (L >= nwg) return false;
        int wgid = (int)L; { const int q = nwg / NXCD, r = nwg % NXCD, xcd = wgid % NXCD, off = wgid / NXCD; wgid = (xcd < r ? xcd * (q + 1) : r * (q + 1) + (xcd - r) * q) + off; }
        const int nig = WGM * nN, gid = wgid / nig, fm = gid * WGM, gsz = (nM - fm) < WGM ? (nM - fm) : WGM;
        u.pm = fm + ((wgid % nig) % gsz); u.pn = (wgid % nig) / gsz; return true;
    }
};
struct PanelOrder {
    int c;
    __device__ bool next(int i, Unit& u) const { if (i >= 2) return false; const int x = c & 7, j = c >> 3; u.pm = 32 * i + 4 * x + (j >> 3); u.pn = j & 7; return true; }
};
template <class Epi, class Sched>
__device__ __forceinline__ void gemm_phase(LAS unsigned char* lds, const Gemm g, const Sched& S, const Epi& E) {
    int tid_ = threadIdx.x; asm volatile("" : "+v"(tid_));
    const int tid = tid_, wid = __builtin_amdgcn_readfirstlane(tid >> 6), lane = tid & 63, wr = wid >> 2, wc = wid & 3, fr = lane & 15, fq = lane >> 4;
    const int K = g.K, nt = K / BK;
    unsigned voffA[2];
#pragma unroll
    for (int i = 0; i < 2; ++i) { int R, C; stage_rc(tid * 16 + i * 8192, R, C); voffA[i] = (unsigned)(R * K + C) * 2u; }
    const size_t kstep = (size_t)(BK * 2);
    const size_t hstep = (size_t)HALF * K * 2;
    const size_t tstep = 2 * hstep;
    const unsigned ldsw = (unsigned)wid * 1024u;
    const int aoff = lds_byte(wr * 64 + fr, fq * 8), boff = lds_byte(wc * 32 + fr, fq * 8);
#define PG8_SA(b, h) (((b) * 2 + (h)) * HTB)
#define PG8_SB(b, h) ((4 + (b) * 2 + (h)) * HTB)
#define PG8_STAGE(bufoff, gbase) do { _Pragma("unroll") for (int _i = 0; _i < 2; ++_i) \
        __builtin_amdgcn_global_load_lds((const unsigned*)((const char*)(gbase) + voffA[_i]), (LAS unsigned*)(lds + (bufoff) + ldsw + _i * 8192), 16, 0, 0); } while (0)
#define PG8_LDA(dst, b, h) do { _Pragma("unroll") for (int m = 0; m < 4; ++m) _Pragma("unroll") for (int k = 0; k < 2; ++k) dst[m][k] = *(const LAS bf16x8*)(lds + PG8_SA(b, h) + aoff + m * 2048 + k * 1024); } while (0)
#define PG8_LDB(dst, b, h) do { _Pragma("unroll") for (int n = 0; n < 2; ++n) _Pragma("unroll") for (int k = 0; k < 2; ++k) dst[n][k] = *(const LAS bf16x8*)(lds + PG8_SB(b, h) + boff + n * 2048 + k * 1024); } while (0)
#define PG8_MMA(ai, bj, At, Bt) do { __builtin_amdgcn_s_setprio(1); _Pragma("unroll") for (int m = 0; m < 4; ++m) _Pragma("unroll") for (int n = 0; n < 2; ++n) _Pragma("unroll") for (int k = 0; k < 2; ++k) \
        acc[ai][bj][m][n] = __builtin_amdgcn_mfma_f32_16x16x32_bf16(Bt[n][k], At[m][k], acc[ai][bj][m][n], 0, 0, 0); __builtin_amdgcn_s_setprio(0); } while (0)
#define PG8_WAIT_V(n) asm volatile("s_waitcnt vmcnt(" #n ")" ::: "memory")
#define PG8_WAIT_L(n) asm volatile("s_waitcnt lgkmcnt(" #n ")" ::: "memory")
#define PG8_BAR __builtin_amdgcn_s_barrier()
#define PG8_SCHED __builtin_amdgcn_sched_barrier(0)
    Unit cur, nxt; int ui = 0;
    if (!S.next(0, cur)) return;
    f32x4 acc[2][2][4][2];
#pragma unroll
    for (int a = 0; a < 2; ++a)
#pragma unroll
        for (int b = 0; b < 2; ++b)
#pragma unroll
            for (int m = 0; m < 4; ++m)
#pragma unroll
                for (int n = 0; n < 2; ++n) acc[a][b][m][n] = (f32x4){0.f, 0.f, 0.f, 0.f};
    bf16x8 At[4][2], B0[2][2], B1[2][2];
    const char* cA = (const char*)g.A + (size_t)cur.pm * tstep; const char* cB = (const char*)g.Bt + (size_t)cur.pn * tstep;
    PG8_STAGE(PG8_SB(0, 0), cB); PG8_STAGE(PG8_SB(0, 1), cB + hstep); PG8_STAGE(PG8_SA(0, 0), cA); PG8_STAGE(PG8_SA(0, 1), cA + hstep);
    if (wr == 1) PG8_BAR;
    PG8_WAIT_V(2); PG8_BAR;
    PG8_STAGE(PG8_SB(1, 0), cB + kstep); PG8_STAGE(PG8_SA(1, 0), cA + kstep); PG8_STAGE(PG8_SB(1, 1), cB + hstep + kstep);
    PG8_WAIT_V(6); PG8_BAR;
    for (;;) {
        const bool has_next = S.next(ui + 1, nxt);
        const char* nA = has_next ? (const char*)g.A + (size_t)nxt.pm * tstep : cA; const char* nB = has_next ? (const char*)g.Bt + (size_t)nxt.pn * tstep : cB;
        for (int t = 0; t < nt; t += 2) {
            const bool last = (t == nt - 2);
            const char* a1 = cA + (size_t)(t + 1) * kstep;
            const char* a2 = last ? nA : cA + (size_t)(t + 2) * kstep; const char* b2 = last ? nB : cB + (size_t)(t + 2) * kstep;
            const char* a3 = a2 + kstep; const char* b3 = b2 + kstep;
            PG8_LDB(B0, 0, 0); PG8_LDB(B1, 0, 1); PG8_SCHED; PG8_LDA(At, 0, 0); PG8_STAGE(PG8_SA(1, 1), a1 + hstep);
            PG8_WAIT_V(8); PG8_WAIT_L(0); PG8_BAR; PG8_MMA(0, 0, At, B0); PG8_MMA(0, 1, At, B1); PG8_BAR; PG8_SCHED;
            PG8_LDA(At, 0, 1); PG8_STAGE(PG8_SB(0, 0), b2); PG8_STAGE(PG8_SB(0, 1), b2 + hstep); PG8_STAGE(PG8_SA(0, 0), a2);
            PG8_WAIT_V(8); PG8_WAIT_L(0); PG8_BAR; PG8_MMA(1, 0, At, B0); PG8_MMA(1, 1, At, B1); PG8_BAR; PG8_SCHED;
            PG8_LDB(B0, 1, 0); PG8_LDB(B1, 1, 1); PG8_SCHED; PG8_LDA(At, 1, 0); PG8_STAGE(PG8_SA(0, 1), a2 + hstep);
            PG8_WAIT_V(8); PG8_WAIT_L(0); PG8_BAR; PG8_MMA(0, 0, At, B0); PG8_MMA(0, 1, At, B1); PG8_BAR; PG8_SCHED;
            PG8_LDA(At, 1, 1); PG8_STAGE(PG8_SB(1, 0), b3); PG8_STAGE(PG8_SB(1, 1), b3 + hstep); PG8_STAGE(PG8_SA(1, 0), a3);
            PG8_WAIT_V(8); PG8_WAIT_L(0); PG8_BAR; PG8_MMA(1, 0, At, B0); PG8_MMA(1, 1, At, B1); PG8_BAR; PG8_SCHED;
        }
        if (wr == 0) PG8_BAR;
        E(acc, cur, wr, wc, fr, fq);
        if (!has_next) break;
#pragma unroll
        for (int a = 0; a < 2; ++a)
#pragma unroll
            for (int b = 0; b < 2; ++b)
#pragma unroll
                for (int m = 0; m < 4; ++m)
#pragma unroll
                    for (int n = 0; n < 2; ++n) acc[a][b][m][n] = (f32x4){0.f, 0.f, 0.f, 0.f};
        cur = nxt; cA = nA; cB = nB; ++ui;
        if (wr == 1) PG8_BAR;
    }
    PG8_WAIT_V(0);
    PG8_BAR;
#undef PG8_SA
#undef PG8_SB
#undef PG8_STAGE
#undef PG8_LDA
#undef PG8_LDB
#undef PG8_MMA
#undef PG8_WAIT_V
#undef PG8_WAIT_L
#undef PG8_BAR
#undef PG8_SCHED
}

struct EpiSwiglu {
    bf16_t* O;
    __device__ __forceinline__ void operator()(const f32x4 (&acc)[2][2][4][2], const Unit& u, int wr, int wc, int fr, int fq) const {
        const int row0 = u.pm * BM + wr * 64 + fr, col0 = u.pn * 128 + wc * 32 + 8 * fq;
#pragma unroll
        for (int ai = 0; ai < 2; ++ai)
#pragma unroll
            for (int m = 0; m < 4; ++m) {
                bf16_t* rowp = O + (size_t)(row0 + ai * HALF + m * 16) * FF + col0;
                const f32x4 g0 = acc[ai][0][m][0], g1 = acc[ai][0][m][1], u0 = acc[ai][1][m][0], u1 = acc[ai][1][m][1];
                f32x4 h0, h1;
#pragma unroll
                for (int j = 0; j < 4; ++j) { h0[j] = siluf_(g0[j]) * u0[j]; h1[j] = siluf_(g1[j]) * u1[j]; }
                u32x4 w; w.x = pk2(h0[0], h0[1]); w.y = pk2(h0[2], h0[3]); w.z = pk2(h1[0], h1[1]); w.w = pk2(h1[2], h1[3]);
                *(u32x4*)rowp = w;
            }
    }
};
struct EpiRes {
    const float* base; float* out; float alpha;
    __device__ __forceinline__ void operator()(const f32x4 (&acc)[2][2][4][2], const Unit& u, int wr, int wc, int fr, int fq) const {
        const int row0 = u.pm * BM + wr * 64 + fr, col0 = u.pn * BM + wc * 32 + 4 * fq;
#pragma unroll
        for (int ai = 0; ai < 2; ++ai) {
            f32x4 b[4][2][2];
#pragma unroll
            for (int m = 0; m < 4; ++m) { const size_t off = (size_t)(row0 + ai * HALF + m * 16) * D + col0;
#pragma unroll
                for (int bj = 0; bj < 2; ++bj)
#pragma unroll
                    for (int n = 0; n < 2; ++n) b[m][bj][n] = *(const f32x4*)(base + off + bj * HALF + n * 16); }
#pragma unroll
            for (int m = 0; m < 4; ++m) { const size_t off = (size_t)(row0 + ai * HALF + m * 16) * D + col0;
#pragma unroll
                for (int bj = 0; bj < 2; ++bj)
#pragma unroll
                    for (int n = 0; n < 2; ++n) *(f32x4*)(out + off + bj * HALF + n * 16) = b[m][bj][n] + alpha * acc[ai][bj][m][n]; }
            asm volatile("" ::: "memory");
        }
    }
};
template <bool FINAL>
struct EpiResNorm {
    const float* base; float* out; float alpha; const float* gain; bf16_t* hb; float* slots; unsigned* cnt;
    __device__ __forceinline__ void operator()(f32x4 (&acc)[2][2][4][2], const Unit& u, int wr, int wc, int fr, int fq) const {
        const int row0 = u.pm * BM + wr * 64 + fr, col0 = u.pn * BM + wc * 32 + 4 * fq;
#pragma unroll
        for (int ai = 0; ai < 2; ++ai)
#pragma unroll
            for (int mp = 0; mp < 2; ++mp) {
                f32x4 b[2][2][2];
#pragma unroll
                for (int mm = 0; mm < 2; ++mm) { const size_t off = (size_t)(row0 + ai * HALF + (2 * mp + mm) * 16) * D + col0;
#pragma unroll
                    for (int bj = 0; bj < 2; ++bj)
#pragma unroll
                        for (int n = 0; n < 2; ++n) b[mm][bj][n] = *(const f32x4*)(base + off + bj * HALF + n * 16); }
#pragma unroll
                for (int mm = 0; mm < 2; ++mm) { const int m = 2 * mp + mm; const int row = row0 + ai * HALF + m * 16; const size_t off = (size_t)row * D + col0;
                    float sq = 0.f;
#pragma unroll
                    for (int bj = 0; bj < 2; ++bj)
#pragma unroll
                        for (int n = 0; n < 2; ++n) { const f32x4 v = b[mm][bj][n] + alpha * acc[ai][bj][m][n]; acc[ai][bj][m][n] = v;
                            if (!FINAL) *(f32x4*)(out + off + bj * HALF + n * 16) = v;
                            sq += (v.x * v.x + v.y * v.y) + (v.z * v.z + v.w * v.w); }
                    sq += __shfl_xor(sq, 16); sq += __shfl_xor(sq, 32);
                    if (fq == 0) __hip_atomic_store((unsigned*)(slots + (size_t)row * 32 + u.pn * 4 + wc), __builtin_bit_cast(unsigned, sq), __ATOMIC_RELAXED, __HIP_MEMORY_SCOPE_AGENT);
                }
                asm volatile("" ::: "memory");
            }
        asm volatile("s_waitcnt vmcnt(0)" ::: "memory");
        if ((threadIdx.x & 63) == 0) __hip_atomic_fetch_add(cnt + 64 * u.pm, 1u, __ATOMIC_RELAXED, __HIP_MEMORY_SCOPE_AGENT);
        if (wr == 0 && wc == 0) {
            unsigned sp = 0u;
            while ((unsigned)__builtin_amdgcn_readfirstlane(__hip_atomic_load(cnt + 64 * u.pm, __ATOMIC_RELAXED, __HIP_MEMORY_SCOPE_AGENT)) < 64u) { __builtin_amdgcn_s_sleep(2); if (++sp > (1u << 21)) break; }
            __builtin_amdgcn_fence(__ATOMIC_ACQUIRE, "agent");
        }
        asm volatile("s_waitcnt vmcnt(0) lgkmcnt(0)" ::: "memory"); __builtin_amdgcn_s_barrier(); asm volatile("" ::: "memory");
        float rs[2][4];
#pragma unroll
        for (int ai = 0; ai < 2; ++ai) {
            f32x4 pa[4], pb[4];
#pragma unroll
            for (int m = 0; m < 4; ++m) { const float* sp4 = slots + (size_t)(row0 + ai * HALF + m * 16) * 32 + fq * 8;
                asm volatile("global_load_dwordx4 %0, %1, off sc0 sc1" : "=v"(pa[m]) : "v"(sp4) : "memory");
                asm volatile("global_load_dwordx4 %0, %1, off offset:16 sc0 sc1" : "=v"(pb[m]) : "v"(sp4) : "memory"); }
            asm volatile("s_waitcnt vmcnt(0)" : "+v"(pa[0]), "+v"(pa[1]), "+v"(pa[2]), "+v"(pa[3]), "+v"(pb[0]), "+v"(pb[1]), "+v"(pb[2]), "+v"(pb[3]) :: "memory");
#pragma unroll
            for (int m = 0; m < 4; ++m) {
                float t = ((pa[m].x + pa[m].y) + (pa[m].z + pa[m].w)) + ((pb[m].x + pb[m].y) + (pb[m].z + pb[m].w));
                t += __shfl_xor(t, 16); t += __shfl_xor(t, 32);
                rs[ai][m] = 1.0f / sqrtf(t * (1.0f / D) + NORM_EPS);
            }
            asm volatile("" ::: "memory");
        }
        f32x4 gw[2][2];
#pragma unroll
        for (int bj = 0; bj < 2; ++bj)
#pragma unroll
            for (int n = 0; n < 2; ++n) gw[bj][n] = *(const f32x4*)(gain + col0 + bj * HALF + n * 16);
#pragma unroll
        for (int ai = 0; ai < 2; ++ai)
#pragma unroll
            for (int m = 0; m < 4; ++m) { const size_t off = (size_t)(row0 + ai * HALF + m * 16) * D + col0; const float r = rs[ai][m];
#pragma unroll
                for (int bj = 0; bj < 2; ++bj) {
                    const f32x4 y0 = acc[ai][bj][m][0] * r * gw[bj][0], y1 = acc[ai][bj][m][1] * r * gw[bj][1];
                    if (FINAL) { *(f32x4*)(out + off + bj * HALF) = y0; *(f32x4*)(out + off + bj * HALF + 16) = y1; }
                    else {
                        unsigned a0 = pk2(y0.x, y0.y), a1 = pk2(y0.z, y0.w), b0 = pk2(y1.x, y1.y), b1 = pk2(y1.z, y1.w);
                        swap16(a0, b0); swap16(a1, b1);
                        *(u32x4*)(hb + off + bj * HALF + ((fq & 1) ? 12 : 0)) = (u32x4){a0, a1, b0, b1};
                    }
                }
            }
    }
};
struct EpiInProj {
    bf16_t* P; const float* cosT; const float* sinT;
    __device__ __forceinline__ void operator()(const f32x4 (&acc)[2][2][4][2], const Unit& u, int wr, int wc, int fr, int fq) const {
        const int row0 = u.pm * BM + wr * 64 + fr;
        if (u.pn < 8) {
#pragma unroll
            for (int ai = 0; ai < 2; ++ai)
#pragma unroll
                for (int m = 0; m < 4; ++m) {
                    const int row = row0 + ai * HALF + m * 16, pos = row & (SEQ - 1);
#pragma unroll
                    for (int bj = 0; bj < 2; ++bj) {
                        const int g = 4 * bj + wc, hl = g >> 1, d0 = (g & 1) * 16 + 4 * fq;
                        const f32x4 c = *(const f32x4*)(cosT + pos * 32 + d0), s = *(const f32x4*)(sinT + pos * 32 + d0);
                        const f32x4 x1 = acc[ai][bj][m][0], x2 = acc[ai][bj][m][1];
                        const float qs = (u.pn < 4) ? 0.125f * 1.4426950408889634f : 1.0f;
                        const f32x4 o1 = (x1 * c - x2 * s) * qs, o2 = (x2 * c + x1 * s) * qs;
                        bf16_t* p = P + (size_t)row * INC + u.pn * BM + hl * 64 + d0;
                        unsigned a0 = pk2(o1[0], o1[1]), a1 = pk2(o1[2], o1[3]), b0 = pk2(o2[0], o2[1]), b1 = pk2(o2[2], o2[3]);
                        swap16(a0, b0); swap16(a1, b1);
                        *(u32x4*)(p + ((fq & 1) ? 28 : 0)) = (u32x4){a0, a1, b0, b1};
                        asm volatile("" ::: "memory");
                    }
                }
        } else {
            const int col0 = u.pn * BM + wc * 32 + 8 * fq;
#pragma unroll
            for (int ai = 0; ai < 2; ++ai)
#pragma unroll
                for (int m = 0; m < 4; ++m) {
                    bf16_t* rowp = P + (size_t)(row0 + ai * HALF + m * 16) * INC + col0;
#pragma unroll
                    for (int bj = 0; bj < 2; ++bj) {
                        const f32x4 v0 = acc[ai][bj][m][0], v1 = acc[ai][bj][m][1];
                        u32x4 w; w.x = pk2(v0[0], v0[1]); w.y = pk2(v0[2], v0[3]); w.z = pk2(v1[0], v1[1]); w.w = pk2(v1[2], v1[3]);
                        *(u32x4*)(rowp + bj * HALF) = w;
                    }
                }
        }
    }
};
}

__device__ __forceinline__ int src_col(int type, int np, int& which) {
    which = 0;
    if (type == 0) return np;
    if (type == 1) { const int pn = np >> 8, lr = np & 255, w = lr & 127; which = lr >> 7; return 128 * pn + (w & ~31) + perm32(w & 31); }
    if (np < 2048) { const int p = np & 255, g = p >> 5, n = (p >> 4) & 1, i = p & 15; return (np & ~255) + (g >> 1) * 64 + (g & 1) * 16 + i + 32 * n; }
    return (np & ~31) + perm32(np & 31);
}
__device__ __forceinline__ void transpose_item(const float* W0, const float* W1, int type, int K, int N, bf16_t* WT, LAS float* scr, int item, int lane) {
    const int nblk_total = item;
    (void)nblk_total;
}
__device__ __forceinline__ void transpose_tile(const float* W0, const float* W1, int type, int K, int Nsrc, bf16_t* WT, LAS float* scr, int kb, int nb, int lane) {
    const int k0 = 64 * kb, n0 = 32 * nb;
    int which; const int sc = src_col(type, n0 + (lane & 31), which);
    const float* src = (which ? W1 : W0) + sc;
#pragma unroll 8
    for (int i = 0; i < 32; ++i) { const int kk = 2 * i + (lane >> 5); scr[kk * 33 + (lane & 31)] = __builtin_nontemporal_load(src + (size_t)(k0 + kk) * Nsrc); }
    asm volatile("s_waitcnt lgkmcnt(0)" ::: "memory");
    const int c = lane & 7;
#pragma unroll
    for (int j = 0; j < 4; ++j) { const int n = (lane >> 3) + 8 * j; const LAS float* s = scr + (8 * c) * 33 + n;
        u32x4 o; o.x = pk2(s[0 * 33], s[1 * 33]); o.y = pk2(s[2 * 33], s[3 * 33]); o.z = pk2(s[4 * 33], s[5 * 33]); o.w = pk2(s[6 * 33], s[7 * 33]);
        __builtin_nontemporal_store(o, (u32x4*)(WT + (size_t)(n0 + n) * K + k0 + 8 * c)); }
    asm volatile("s_waitcnt lgkmcnt(0)" ::: "memory");
}
__device__ __forceinline__ void prep_phase(LAS unsigned char* lds, const Params& p) {
    int tid_ = threadIdx.x; asm volatile("" : "+v"(tid_));
    const int tid = tid_, lane = tid & 63, wave = __builtin_amdgcn_readfirstlane(tid >> 6);
    LAS float* scr = (LAS float*)(lds + wave * 16384);
    const int gw = BID() * 8 + wave, NGW = GSZ() * 8;
    constexpr int I_GU = (D / 64) * (NGU / 32), I_DN = (FF / 64) * (D / 32), I_IN = (D / 64) * (INC / 32), I_WO = (D / 64) * (D / 32);
    constexpr int I_LAYER = 2 * I_GU + 2 * I_DN + I_IN + I_WO;
    for (int it = gw; it < DEPTH * I_LAYER; it += NGW) {
        const int l = it / I_LAYER; int r = it - l * I_LAYER;
        unsigned char* wl = p.ws + WS_W + (size_t)l * LW_BYTES;
        if (r < I_GU) { const int nblk = NGU / 32; transpose_tile(p.ffn1_wg + (size_t)l * D * FF, p.ffn1_wu + (size_t)l * D * FF, 1, D, FF, (bf16_t*)(wl + LW_GU1), scr, r / nblk, r % nblk, lane); continue; } r -= I_GU;
        if (r < I_DN) { const int nblk = D / 32; transpose_tile(p.ffn1_wd + (size_t)l * FF * D, nullptr, 0, FF, D, (bf16_t*)(wl + LW_D1), scr, r / nblk, r % nblk, lane); continue; } r -= I_DN;
        if (r < I_IN) { const int nblk = INC / 32; transpose_tile(p.w_in + (size_t)l * D * INC, nullptr, 2, D, INC, (bf16_t*)(wl + LW_IN), scr, r / nblk, r % nblk, lane); continue; } r -= I_IN;
        if (r < I_WO) { const int nblk = D / 32; transpose_tile(p.w_out + (size_t)l * D * D, nullptr, 0, D, D, (bf16_t*)(wl + LW_WO), scr, r / nblk, r % nblk, lane); continue; } r -= I_WO;
        if (r < I_GU) { const int nblk = NGU / 32; transpose_tile(p.ffn2_wg + (size_t)l * D * FF, p.ffn2_wu + (size_t)l * D * FF, 1, D, FF, (bf16_t*)(wl + LW_GU2), scr, r / nblk, r % nblk, lane); continue; } r -= I_GU;
        { const int nblk = D / 32; transpose_tile(p.ffn2_wd + (size_t)l * FF * D, nullptr, 0, FF, D, (bf16_t*)(wl + LW_D2), scr, r / nblk, r % nblk, lane); }
    }
    float* cosT = (float*)(p.ws + WS_COS); float* sinT = (float*)(p.ws + WS_SIN);
    for (int i = BID() * 512 + tid; i < SEQ * 32; i += GSZ() * 512) {
        const int pos = i >> 5, d = i & 31;
        const float inv_freq = (float)exp2(-(double)d * (13.287712379549449 / 32.0));
        const float ang = (float)pos * inv_freq;
        double rev = (double)ang * 0.15915494309189535; rev -= rint(rev);
        const float rf = (float)rev;
        cosT[i] = __builtin_amdgcn_cosf(rf); sinT[i] = __builtin_amdgcn_sinf(rf);
    }
}

template <bool FINAL>
__device__ __forceinline__ void norm_phase(const float* x, const float* w, bf16_t* hb, float* outf) {
    int tid_ = threadIdx.x; asm volatile("" : "+v"(tid_));
    const int tid = tid_, lane = tid & 63, wave = tid >> 6;
    const int gw = BID() * 8 + wave, NGW = GSZ() * 8;
    for (int row = gw; row < M; row += NGW) {
        const f32x4* xr = (const f32x4*)(x + (size_t)row * D) + lane;
        f32x4 v[8]; float s = 0.f;
#pragma unroll
        for (int j = 0; j < 8; ++j) { v[j] = xr[64 * j]; s += (v[j].x * v[j].x + v[j].y * v[j].y) + (v[j].z * v[j].z + v[j].w * v[j].w); }
        const float r = 1.0f / sqrtf(wave_sum(s) * (1.0f / D) + NORM_EPS);
#pragma unroll
        for (int j = 0; j < 8; ++j) {
            const f32x4 w4 = ((const f32x4*)w)[lane + 64 * j];
            const f32x4 y = v[j] * r * w4;
            if (FINAL) ((f32x4*)(outf + (size_t)row * D))[lane + 64 * j] = y;
            else { u32x2 o; o.x = pk2(y.x, y.y); o.y = pk2(y.z, y.w); ((u32x2*)(hb + (size_t)row * D))[lane + 64 * j] = o; }
        }
    }
}

constexpr int ATT_K0 = 0, ATT_V0 = 32768, ATT_X = 65536, ATT_XS = 132;
__device__ __forceinline__ void attn_block(LAS unsigned char* lds, const bf16_t* P, bf16_t* mix, int b, int h, int qb, float lam, float outscale, const float* subln) {
    int tid_ = threadIdx.x; asm volatile("" : "+v"(tid_));
    const int tid = tid_, lane = tid & 63, wave = __builtin_amdgcn_readfirstlane(tid >> 6), r32 = lane & 31, hi = lane >> 5;
    const int comp = wave >> 2, wq = wave & 3;
    const int rb = b * SEQ, q0 = qb * 128, qw0 = q0 + wq * 32, qrow = qw0 + r32;
    const float C1 = 0.125f * 1.4426950408889634f;
    bf16x8 qf[4];
    { const bf16_t* qp = P + (size_t)(rb + qrow) * INC + COL_AQ + h * 128 + comp * 64 + hi * 8;
#pragma unroll
      for (int ks = 0; ks < 4; ++ks) qf[ks] = *(const bf16x8*)(qp + 16 * ks); }
    const int ntiles = 2 * qb + 2;
    const int srow = tid >> 4, sch = tid & 15;
    const bf16_t* kg = P + (size_t)rb * INC + COL_AK + h * 128 + sch * 8;
    const bf16_t* vg = P + (size_t)rb * INC + COL_AV + h * 128 + sch * 8;
    const unsigned so0 = off_b(srow, sch), so1 = off_b(srow + 32, sch);
    u32x4 kr0, kr1, vr0, vr1;
    kr0 = *(const u32x4*)(kg + (size_t)srow * INC); kr1 = *(const u32x4*)(kg + (size_t)(srow + 32) * INC);
    vr0 = *(const u32x4*)(vg + (size_t)srow * INC); vr1 = *(const u32x4*)(vg + (size_t)(srow + 32) * INC);
    *(LAS u32x4*)(lds + ATT_K0 + so0) = kr0; *(LAS u32x4*)(lds + ATT_K0 + so1) = kr1;
    *(LAS u32x4*)(lds + ATT_V0 + so0) = vr0; *(LAS u32x4*)(lds + ATT_V0 + so1) = vr1;
    float mrun = -INFINITY, lrun = 0.f;
    f32x16 o[4];
#pragma unroll
    for (int c = 0; c < 4; ++c)
#pragma unroll
        for (int j = 0; j < 16; ++j) o[c][j] = 0.f;
    const int blk = (lane >> 4) & 1, qq = (lane & 15) >> 2, pp = lane & 3;
    unsigned kbase[4], vbase[4][2];
#pragma unroll
    for (int ks = 0; ks < 4; ++ks) kbase[ks] = off_b(r32, comp * 8 + 2 * ks + hi);
#pragma unroll
    for (int c = 0; c < 4; ++c)
#pragma unroll
        for (int t = 0; t < 2; ++t) vbase[c][t] = off_b(8 * t + 4 * hi + qq, 4 * c + 2 * blk + (pp >> 1)) + 8 * (pp & 1);
    asm volatile("" :: "v"(qf[0]), "v"(qf[1]), "v"(qf[2]), "v"(qf[3]));
    for (int kt = 0; kt < ntiles; ++kt) {
        __syncthreads();
        const int buf = kt & 1;
        if (kt + 1 < ntiles) {
            const size_t ro = (size_t)(64 * (kt + 1)) * INC;
            kr0 = *(const u32x4*)(kg + ro + (size_t)srow * INC); kr1 = *(const u32x4*)(kg + ro + (size_t)(srow + 32) * INC);
            vr0 = *(const u32x4*)(vg + ro + (size_t)srow * INC); vr1 = *(const u32x4*)(vg + ro + (size_t)(srow + 32) * INC);
        }
        const int kb = 64 * kt;
        if (kb <= qw0 + 31) {
            LAS const unsigned char* Kb = lds + ATT_K0 + buf * 16384;
            LAS const unsigned char* Vb = lds + ATT_V0 + buf * 16384;
            f32x16 s0, s1;
#pragma unroll
            for (int j = 0; j < 16; ++j) { s0[j] = 0.f; s1[j] = 0.f; }
            bf16x8 ka[4][2];
#pragma unroll
            for (int ks = 0; ks < 4; ++ks) { ka[ks][0] = *(const LAS bf16x8*)(Kb + kbase[ks]); ka[ks][1] = *(const LAS bf16x8*)(Kb + kbase[ks] + 8192); }
            __builtin_amdgcn_sched_barrier(0);
#pragma unroll
            for (int ks = 0; ks < 4; ++ks) {
                s0 = __builtin_amdgcn_mfma_f32_32x32x16_bf16(ka[ks][0], qf[ks], s0, 0, 0, 0);
                s1 = __builtin_amdgcn_mfma_f32_32x32x16_bf16(ka[ks][1], qf[ks], s1, 0, 0, 0);
            }
            if (kb + 63 > qw0) {
#pragma unroll
                for (int j = 0; j < 16; ++j) { const int key = kb + crow(j, hi); if (key > qrow) s0[j] = -INFINITY; if (key + 32 > qrow) s1[j] = -INFINITY; }
            }
            float mxa = max3f(s0[0], s1[0], s0[1]), mxb = max3f(s1[1], s0[2], s1[2]), mxc = max3f(s0[3], s1[3], s0[4]), mxd = max3f(s1[4], s0[5], s1[5]);
            mxa = max3f(mxa, s0[6], s1[6]); mxb = max3f(mxb, s0[7], s1[7]); mxc = max3f(mxc, s0[8], s1[8]); mxd = max3f(mxd, s0[9], s1[9]);
            mxa = max3f(mxa, s0[10], s1[10]); mxb = max3f(mxb, s0[11], s1[11]); mxc = max3f(mxc, s0[12], s1[12]); mxd = max3f(mxd, s0[13], s1[13]);
            mxa = max3f(mxa, s0[14], s1[14]); mxb = max3f(mxb, s0[15], s1[15]);
            float mx = max3f(mxa, mxb, max3f(mxc, mxd, mxd));
            { auto rr = __builtin_amdgcn_permlane32_swap(__builtin_bit_cast(unsigned, mx), __builtin_bit_cast(unsigned, mx), false, false);
              mx = fmaxf(__builtin_bit_cast(float, rr[0]), __builtin_bit_cast(float, rr[1])); }
            if (__any(mx > mrun + 8.0f)) {
                const float mnew = fmaxf(mrun, mx); const float alpha = __builtin_amdgcn_exp2f(mrun - mnew); mrun = mnew; lrun *= alpha;
#pragma unroll
                for (int c = 0; c < 4; ++c)
#pragma unroll
                    for (int j = 0; j < 16; ++j) o[c][j] *= alpha;
            }
#pragma unroll
            for (int j = 0; j < 16; ++j) { s0[j] = __builtin_amdgcn_exp2f(s0[j] - mrun); s1[j] = __builtin_amdgcn_exp2f(s1[j] - mrun); }
            float ps0 = 0.f, ps1 = 0.f, ps2 = 0.f, ps3 = 0.f;
#pragma unroll
            for (int j = 0; j < 16; j += 2) { ps0 += s0[j]; ps1 += s1[j]; ps2 += s0[j + 1]; ps3 += s1[j + 1]; }
            lrun += (ps0 + ps1) + (ps2 + ps3);
            bf16x8 pb[4];
#pragma unroll
            for (int s2 = 0; s2 < 2; ++s2) {
                u32x4 w0, w1;
                w0.x = pk2(s0[8 * s2 + 0], s0[8 * s2 + 1]); w0.y = pk2(s0[8 * s2 + 2], s0[8 * s2 + 3]); w0.z = pk2(s0[8 * s2 + 4], s0[8 * s2 + 5]); w0.w = pk2(s0[8 * s2 + 6], s0[8 * s2 + 7]);
                w1.x = pk2(s1[8 * s2 + 0], s1[8 * s2 + 1]); w1.y = pk2(s1[8 * s2 + 2], s1[8 * s2 + 3]); w1.z = pk2(s1[8 * s2 + 4], s1[8 * s2 + 5]); w1.w = pk2(s1[8 * s2 + 6], s1[8 * s2 + 7]);
                pb[s2] = __builtin_bit_cast(bf16x8, w0); pb[2 + s2] = __builtin_bit_cast(bf16x8, w1);
            }
#pragma unroll
            for (int s = 0; s < 4; ++s) {
#pragma unroll
                for (int c = 0; c < 4; ++c) {
                    const s16x4 v0 = vtr(Vb + vbase[c][0] + 4096 * s);
                    const s16x4 v1 = vtr(Vb + vbase[c][1] + 4096 * s);
                    o[c] = __builtin_amdgcn_mfma_f32_32x32x16_bf16(cat8(v0, v1), pb[s], o[c], 0, 0, 0);
                }
            }
        }
        if (kt + 1 < ntiles) {
            const int nb = (kt + 1) & 1;
            *(LAS u32x4*)(lds + ATT_K0 + nb * 16384 + so0) = kr0; *(LAS u32x4*)(lds + ATT_K0 + nb * 16384 + so1) = kr1;
            *(LAS u32x4*)(lds + ATT_V0 + nb * 16384 + so0) = vr0; *(LAS u32x4*)(lds + ATT_V0 + nb * 16384 + so1) = vr1;
        }
    }
    const float ltot = lrun + __shfl_xor(lrun, 32);
    const float inv = 1.0f / ltot;
    LAS float* X = (LAS float*)(lds + ATT_X) + (wq * 32 + r32) * ATT_XS;
    if (comp == 1) {
        const float sc = lam * inv;
#pragma unroll
        for (int c = 0; c < 4; ++c)
#pragma unroll
            for (int jj = 0; jj < 4; ++jj) { f32x4 v = {o[c][4 * jj] * sc, o[c][4 * jj + 1] * sc, o[c][4 * jj + 2] * sc, o[c][4 * jj + 3] * sc}; *(LAS f32x4*)(X + 32 * c + 8 * jj + 4 * hi) = v; }
    }
    __syncthreads();
    if (comp == 0) {
        float ss = 0.f;
#pragma unroll
        for (int c = 0; c < 4; ++c)
#pragma unroll
            for (int jj = 0; jj < 4; ++jj) {
                const f32x4 x2 = *(const LAS f32x4*)(X + 32 * c + 8 * jj + 4 * hi);
#pragma unroll
                for (int e = 0; e < 4; ++e) { const float v = o[c][4 * jj + e] * inv - x2[e]; o[c][4 * jj + e] = v; ss += v * v; }
            }
        ss += __shfl_xor(ss, 32);
        const float rms = outscale / sqrtf(ss * (1.0f / 128.0f) + NORM_EPS);
        bf16_t* op = mix + (size_t)(rb + qrow) * D + h * 128;
#pragma unroll
        for (int c = 0; c < 4; ++c)
#pragma unroll
            for (int jp = 0; jp < 2; ++jp) {
                const int j0 = 8 * jp, dv0 = 32 * c + 16 * jp + 4 * hi;
                const f32x4 wa = *(const f32x4*)(subln + dv0), wb = *(const f32x4*)(subln + dv0 + 8);
                unsigned a0 = pk2(o[c][j0] * rms * wa[0], o[c][j0 + 1] * rms * wa[1]), a1 = pk2(o[c][j0 + 2] * rms * wa[2], o[c][j0 + 3] * rms * wa[3]);
                unsigned b0 = pk2(o[c][j0 + 4] * rms * wb[0], o[c][j0 + 5] * rms * wb[1]), b1 = pk2(o[c][j0 + 6] * rms * wb[2], o[c][j0 + 7] * rms * wb[3]);
                swap32(a0, b0); swap32(a1, b1);
                *(u32x4*)(op + 32 * c + 16 * jp + (hi ? 8 : 0)) = (u32x4){a0, a1, b0, b1};
            }
    }
}
__device__ __forceinline__ void attn_phase(LAS unsigned char* lds, const Params& p, int layer) {
    const bf16_t* P = (const bf16_t*)(p.ws + WS_BIG); bf16_t* mix = (bf16_t*)(p.ws + WS_HB);
    float d1 = 0.f, d2 = 0.f;
    for (int i = 0; i < 64; ++i) { d1 += p.lq1[layer * 64 + i] * p.lk1[layer * 64 + i]; d2 += p.lq2[layer * 64 + i] * p.lk2[layer * 64 + i]; }
    const float lambda_init = 0.8f - 0.6f * expf(-0.3f * (float)layer);
    const float lam = expf(d1) - expf(d2) + lambda_init;
    const float* subln = p.subln + layer * 128;
    const int nblk = GSZ(), bid = BID();
    for (int it0 = bid; it0 < 512; it0 += nblk) {
        int it = it0;
        if (nblk == 256) { const int x = bid & 7, j = bid >> 3, r = it0 >> 8; it = (2 * x + r) * 32 + j; }
        const int bh = it >> 5, pr = it & 31, b = bh >> 3, h = bh & 7;
        attn_block(lds, P, mix, b, h, pr, lam, 1.0f - lambda_init, subln);
        __syncthreads();
        attn_block(lds, P, mix, b, h, 63 - pr, lam, 1.0f - lambda_init, subln);
        __syncthreads();
    }
}

constexpr int HG_QI = 0, HG_QH = 16384, HG_KH = 32768, HG_V = 49152, HG_ST = 65536, HG_TOT = 98304, HG_OS = 100352, HG_OSS = 132;
__device__ __forceinline__ float hgrn_lb(const Params& p, int layer, int idx) {
    if (layer == 0) return 0.f;
    const float a = p.hlb[idx], b = p.hlb[1024 + idx];
    return 1.0f / (1.0f + expf(a - b));
}
#define HG_LBAR() do { asm volatile("s_waitcnt lgkmcnt(0)" ::: "memory"); __builtin_amdgcn_s_barrier(); asm volatile("" ::: "memory"); } while (0)
__device__ __forceinline__ void hgrn_p1(LAS unsigned char* lds, const Params& p, int layer) {
    int tid_ = threadIdx.x; asm volatile("" : "+v"(tid_));
    const int tid = tid_, lane = tid & 63, wave = __builtin_amdgcn_readfirstlane(tid >> 6), r32 = lane & 31, hi = lane >> 5;
    const bf16_t* P = (const bf16_t*)(p.ws + WS_BIG); bf16_t* HST = (bf16_t*)(p.ws + WS_HST); float* HDEC = (float*)(p.ws + WS_HDEC);
    const int k = tid & 127, seg = tid >> 7;
    LAS float* tot = (LAS float*)(lds + HG_TOT);
    const int blk = (lane >> 4) & 1, qq = (lane & 15) >> 2, pp = lane & 3;
    const int nblk = GSZ();
#define P1_LOAD(item_) do { const int bh_ = (item_) >> 7, c_ = (item_) & 127, b_ = bh_ >> 3, h_ = bh_ & 7; const size_t row0_ = (size_t)b_ * SEQ + 64 * c_; \
        const bf16_t* fp_ = P + (row0_ + 16 * seg) * INC + COL_RF + h_ * 128 + k; \
        _Pragma("unroll") for (int i = 0; i < 16; ++i) fr[i] = fp_[(size_t)i * INC]; \
        _Pragma("unroll") for (int i = 0; i < 2; ++i) { const int idx = tid + 512 * i, row = idx >> 4, ch = idx & 15; vr[i] = *(const u32x4*)(P + (row0_ + row) * INC + COL_RI + h_ * 128 + ch * 8); } \
        lbn = hgrn_lb(p, layer, h_ * 128 + k); } while (0)
    bf16_t fr[16]; u32x4 vr[2]; float lbn = 0.f;
    int item = BID();
    if (item < 2048) P1_LOAD(item);
    for (; item < 2048; item += nblk) {
        const float lb = lbn;
        float bc[16], kk[16]; float run = 0.f;
#pragma unroll
        for (int i = 0; i < 16; ++i) {
            const float fl = bf2f(fr[i]);
            const float sg = sigmoidf_(fl), f = lb + (1.0f - lb) * sg;
            run += flog(f); bc[i] = run; kk[i] = (1.0f - lb) * sigmoidf_(-fl);
        }
        tot[seg * 128 + k] = run;
#pragma unroll
        for (int i = 0; i < 2; ++i) { const int idx = tid + 512 * i, row = idx >> 4, ch = idx & 15; *(LAS u32x4*)(lds + HG_V + off_b(row, ch)) = vr[i]; }
        HG_LBAR();
        float offs = 0.f, blast = 0.f;
#pragma unroll
        for (int s = 0; s < 4; ++s) { const float t = tot[s * 128 + k]; blast += t; if (s < seg) offs += t; }
#pragma unroll
        for (int i = 0; i < 16; ++i) {
            const float kt = kk[i] * fexp(blast - (bc[i] + offs));
            *(LAS bf16_t*)(lds + HG_KH + off_b(16 * seg + i, k >> 3) + (k & 7) * 2) = (bf16_t)f2bf(kt);
        }
        if (seg == 0) HDEC[(size_t)item * 128 + k] = fexp(blast);
        if (item + nblk < 2048) P1_LOAD(item + nblk);
        HG_LBAR();
        const int ktile = wave >> 1, vt0 = 2 * (wave & 1);
        f32x16 acc[2];
#pragma unroll
        for (int j = 0; j < 16; ++j) { acc[0][j] = 0.f; acc[1][j] = 0.f; }
#pragma unroll
        for (int ks = 0; ks < 4; ++ks) {
            const unsigned r0 = 16 * ks + 8 * hi + qq;
            const s16x4 a0 = vtr(lds + HG_KH + off_b(r0, 4 * ktile + 2 * blk + (pp >> 1)) + 8 * (pp & 1));
            const s16x4 a1 = vtr(lds + HG_KH + off_b(r0 + 4, 4 * ktile + 2 * blk + (pp >> 1)) + 8 * (pp & 1));
            const bf16x8 af = cat8(a0, a1);
#pragma unroll
            for (int vi = 0; vi < 2; ++vi) {
                const s16x4 b0 = vtr(lds + HG_V + off_b(r0, 4 * (vt0 + vi) + 2 * blk + (pp >> 1)) + 8 * (pp & 1));
                const s16x4 b1 = vtr(lds + HG_V + off_b(r0 + 4, 4 * (vt0 + vi) + 2 * blk + (pp >> 1)) + 8 * (pp & 1));
                acc[vi] = __builtin_amdgcn_mfma_f32_32x32x16_bf16(af, cat8(b0, b1), acc[vi], 0, 0, 0);
            }
        }
        bf16_t* st = HST + (size_t)item * 16384;
#pragma unroll
        for (int vi = 0; vi < 2; ++vi) {
            const int v = 32 * (vt0 + vi) + r32;
#pragma unroll
            for (int jp = 0; jp < 2; ++jp) {
                const int j0 = 8 * jp;
                unsigned a0 = pk2(acc[vi][j0], acc[vi][j0 + 1]), a1 = pk2(acc[vi][j0 + 2], acc[vi][j0 + 3]), b0 = pk2(acc[vi][j0 + 4], acc[vi][j0 + 5]), b1 = pk2(acc[vi][j0 + 6], acc[vi][j0 + 7]);
                swap32(a0, b0); swap32(a1, b1);
                *(u32x4*)(st + v * 128 + 32 * ktile + 16 * jp + (hi ? 8 : 0)) = (u32x4){a0, a1, b0, b1};
            }
        }
        HG_LBAR();
    }
#undef P1_LOAD
}
__device__ __forceinline__ void hgrn_p2(const Params& p) {
    bf16_t* HST = (bf16_t*)(p.ws + WS_HST); const float* HDEC = (const float*)(p.ws + WS_HDEC);
    const int gid = BID() * 512 + threadIdx.x, nth = GSZ() * 512;
    for (int u = gid; u < 16 * 4096; u += nth) {
        const int bh = u >> 12, e4 = (u & 4095) * 4, k0 = e4 & 127;
        bf16_t* base = HST + (size_t)bh * 128 * 16384 + e4;
        const float* dbase = HDEC + (size_t)bh * 128 * 128 + k0;
        f32x4 st = {0.f, 0.f, 0.f, 0.f};
        u32x2 LA[8], LB[8]; f32x4 dA[8], dB[8];
#define P2_LOAD(LX, DX, c0_) do { _Pragma("unroll") for (int i = 0; i < 8; ++i) { LX[i] = *(const u32x2*)(base + (size_t)((c0_) + i) * 16384); DX[i] = *(const f32x4*)(dbase + (size_t)((c0_) + i) * 128); } } while (0)
#define P2_RUN(LX, DX, c0_) do { _Pragma("unroll") for (int i = 0; i < 8; ++i) { \
            u32x2 w; w.x = pk2(st[0], st[1]); w.y = pk2(st[2], st[3]); *(u32x2*)(base + (size_t)((c0_) + i) * 16384) = w; \
            st[0] = DX[i][0] * st[0] + bflo(LX[i].x); st[1] = DX[i][1] * st[1] + bfhi(LX[i].x); \
            st[2] = DX[i][2] * st[2] + bflo(LX[i].y); st[3] = DX[i][3] * st[3] + bfhi(LX[i].y); } } while (0)
        P2_LOAD(LA, dA, 0);
        for (int c0 = 0; c0 < 128; c0 += 16) {
            P2_LOAD(LB, dB, c0 + 8);
            P2_RUN(LA, dA, c0);
            if (c0 + 16 < 128) P2_LOAD(LA, dA, c0 + 16);
            P2_RUN(LB, dB, c0 + 8);
        }
#undef P2_LOAD
#undef P2_RUN
    }
}
__device__ __forceinline__ void hgrn_p3(LAS unsigned char* lds, const Params& p, int layer) {
    int tid_ = threadIdx.x; asm volatile("" : "+v"(tid_));
    const int tid = tid_, lane = tid & 63, wave = __builtin_amdgcn_readfirstlane(tid >> 6), r32 = lane & 31, hi = lane >> 5;
    const bf16_t* P = (const bf16_t*)(p.ws + WS_BIG); const bf16_t* HST = (const bf16_t*)(p.ws + WS_HST); bf16_t* mix = (bf16_t*)(p.ws + WS_HB);
    const float* gw = p.gnorm + layer * 128;
    const int k = tid & 127, seg = tid >> 7;
    LAS float* tot = (LAS float*)(lds + HG_TOT);
    LAS float* OS = (LAS float*)(lds + HG_OS);
    const int blk = (lane >> 4) & 1, qq = (lane & 15) >> 2, pp = lane & 3;
    const int nblk = GSZ();
#define P3_LOAD(item_) do { const int bh_ = (item_) >> 7, c_ = (item_) & 127, b_ = bh_ >> 3, h_ = bh_ & 7; const size_t row0_ = (size_t)b_ * SEQ + 64 * c_; \
        const bf16_t* fp_ = P + (row0_ + 16 * seg) * INC + COL_RF + h_ * 128 + k; const bf16_t* qp_ = P + (row0_ + 16 * seg) * INC + COL_RQ + h_ * 128 + k; \
        _Pragma("unroll") for (int i = 0; i < 16; ++i) { fr[i] = fp_[(size_t)i * INC]; qr[i] = qp_[(size_t)i * INC]; } \
        _Pragma("unroll") for (int i = 0; i < 2; ++i) { const int idx = tid + 512 * i, row = idx >> 4, ch = idx & 15; vr[i] = *(const u32x4*)(P + (row0_ + row) * INC + COL_RI + h_ * 128 + ch * 8); } \
        lbn = hgrn_lb(p, layer, h_ * 128 + k); } while (0)
    bf16_t fr[16], qr[16]; u32x4 vr[2]; float lbn = 0.f;
    int item = BID();
    if (item < 2048) P3_LOAD(item);
    for (; item < 2048; item += nblk) {
        const int bh = item >> 7, c = item & 127, b = bh >> 3, h = bh & 7;
        const size_t row0 = (size_t)b * SEQ + 64 * c;
        const float lb = lbn;
        u32x4 str[4];
#pragma unroll
        for (int i = 0; i < 4; ++i) { const int idx = tid + 512 * i, row = idx >> 4, ch = idx & 15; str[i] = *(const u32x4*)(HST + (size_t)item * 16384 + row * 128 + ch * 8); }
        float bc[16], kk[16], qv[16]; float run = 0.f;
#pragma unroll
        for (int i = 0; i < 16; ++i) {
            const float fl = bf2f(fr[i]);
            const float sg = sigmoidf_(fl), f = lb + (1.0f - lb) * sg;
            run += flog(f); bc[i] = run; kk[i] = (1.0f - lb) * sigmoidf_(-fl);
            qv[i] = siluf_(bf2f(qr[i]));
        }
        tot[seg * 128 + k] = run;
#pragma unroll
        for (int i = 0; i < 2; ++i) { const int idx = tid + 512 * i, row = idx >> 4, ch = idx & 15; *(LAS u32x4*)(lds + HG_V + off_b(row, ch)) = vr[i]; }
#pragma unroll
        for (int i = 0; i < 4; ++i) { const int idx = tid + 512 * i, row = idx >> 4, ch = idx & 15; *(LAS u32x4*)(lds + HG_ST + off_b(row, ch)) = str[i]; }
        HG_LBAR();
        float offs = 0.f;
#pragma unroll
        for (int s = 0; s < 4; ++s) { const float t = tot[s * 128 + k]; if (s < seg) offs += t; }
        const float ref = tot[k] + tot[128 + k];
#pragma unroll
        for (int i = 0; i < 16; ++i) {
            const float bt = bc[i] + offs;
            const unsigned a = off_b(16 * seg + i, k >> 3) + (k & 7) * 2;
            *(LAS bf16_t*)(lds + HG_QI + a) = (bf16_t)f2bf(qv[i] * fexp(bt));
            *(LAS bf16_t*)(lds + HG_QH + a) = (bf16_t)f2bf(qv[i] * fexp(fminf(bt - ref, 80.f)));
            *(LAS bf16_t*)(lds + HG_KH + a) = (bf16_t)f2bf(kk[i] * fexp(fminf(ref - bt, 80.f)));
        }
        if (item + nblk < 2048) P3_LOAD(item + nblk);
        const u32x4* gp = (const u32x4*)(P + (row0 + (tid >> 3)) * INC + COL_RG + h * 128 + (tid & 7) * 16);
        const u32x4 g0 = gp[0], g1 = gp[1];
        HG_LBAR();
        const int vt = wave & 3, tt = wave >> 2;
        f32x16 o;
#pragma unroll
        for (int j = 0; j < 16; ++j) o[j] = 0.f;
#pragma unroll
        for (int ks = 0; ks < 8; ++ks) {
            const bf16x8 a = *(const LAS bf16x8*)(lds + HG_ST + off_b(32 * vt + r32, 2 * ks + hi));
            const bf16x8 bq = *(const LAS bf16x8*)(lds + HG_QI + off_b(32 * tt + r32, 2 * ks + hi));
            o = __builtin_amdgcn_mfma_f32_32x32x16_bf16(a, bq, o, 0, 0, 0);
        }
        for (int st = 0; st <= tt; ++st) {
            f32x16 sc;
#pragma unroll
            for (int j = 0; j < 16; ++j) sc[j] = 0.f;
#pragma unroll
            for (int ks = 0; ks < 8; ++ks) {
                const bf16x8 a = *(const LAS bf16x8*)(lds + HG_KH + off_b(32 * st + r32, 2 * ks + hi));
                const bf16x8 bq = *(const LAS bf16x8*)(lds + HG_QH + off_b(32 * tt + r32, 2 * ks + hi));
                sc = __builtin_amdgcn_mfma_f32_32x32x16_bf16(a, bq, sc, 0, 0, 0);
            }
            if (st == tt) {
#pragma unroll
                for (int j = 0; j < 16; ++j) if (crow(j, hi) > r32) sc[j] = 0.f;
            }
#pragma unroll
            for (int s2 = 0; s2 < 2; ++s2) {
                u32x4 w; w.x = pk2(sc[8 * s2 + 0], sc[8 * s2 + 1]); w.y = pk2(sc[8 * s2 + 2], sc[8 * s2 + 3]); w.z = pk2(sc[8 * s2 + 4], sc[8 * s2 + 5]); w.w = pk2(sc[8 * s2 + 6], sc[8 * s2 + 7]);
                const bf16x8 pbv = __builtin_bit_cast(bf16x8, w);
                const unsigned r0 = 32 * st + 16 * s2 + 4 * hi + qq;
                const s16x4 v0 = vtr(lds + HG_V + off_b(r0, 4 * vt + 2 * blk + (pp >> 1)) + 8 * (pp & 1));
                const s16x4 v1 = vtr(lds + HG_V + off_b(r0 + 8, 4 * vt + 2 * blk + (pp >> 1)) + 8 * (pp & 1));
                o = __builtin_amdgcn_mfma_f32_32x32x16_bf16(cat8(v0, v1), pbv, o, 0, 0, 0);
            }
        }
#pragma unroll
        for (int jj = 0; jj < 4; ++jj) { f32x4 v = {o[4 * jj], o[4 * jj + 1], o[4 * jj + 2], o[4 * jj + 3]};
            *(LAS f32x4*)(OS + (32 * tt + r32) * HG_OSS + 32 * vt + 8 * jj + 4 * hi) = v; }
        HG_LBAR();
        {
            const int t = tid >> 3, vs = (tid & 7) * 16;
            f32x4 x[4]; float ss = 0.f;
#pragma unroll
            for (int i = 0; i < 4; ++i) { x[i] = *(const LAS f32x4*)(OS + t * HG_OSS + vs + 4 * i); ss += (x[i].x * x[i].x + x[i].y * x[i].y) + (x[i].z * x[i].z + x[i].w * x[i].w); }
            ss += __shfl_xor(ss, 1); ss += __shfl_xor(ss, 2); ss += __shfl_xor(ss, 4);
            const float rms = 1.0f / sqrtf(ss * (1.0f / 128.0f) + NORM_EPS);
            const unsigned gwd[8] = {g0.x, g0.y, g0.z, g0.w, g1.x, g1.y, g1.z, g1.w};
            unsigned ow[8];
#pragma unroll
            for (int i = 0; i < 8; ++i) {
                const float ga = bflo(gwd[i]), gb = bfhi(gwd[i]);
                const float xa = x[i >> 1][(i & 1) * 2], xb = x[i >> 1][(i & 1) * 2 + 1];
                ow[i] = pk2(xa * rms * gw[vs + 2 * i] * siluf_(ga), xb * rms * gw[vs + 2 * i + 1] * siluf_(gb));
            }
            u32x4* op = (u32x4*)(mix + (row0 + t) * D + 1024 + h * 128 + vs);
            op[0] = (u32x4){ow[0], ow[1], ow[2], ow[3]}; op[1] = (u32x4){ow[4], ow[5], ow[6], ow[7]};
        }
        HG_LBAR();
    }
#undef P3_LOAD
}

#define XB_TMO      128
#define XB_XCNT(j)  (256  + 64 * (j))
#define XB_XSUB(j)  (1280 + 64 * (j))
#define XB_XGEN(j)  (2304 + 64 * (j))
#define XB_TOP      3328
#define XB_TOPGEN   3392
#define XCD_BAR_WORDS 3456
#define XB_SPIN_CAP (1u << 22)
__device__ __forceinline__ unsigned xb_ld(unsigned* p)              { return __hip_atomic_load(p, __ATOMIC_RELAXED, __HIP_MEMORY_SCOPE_AGENT); }
__device__ __forceinline__ unsigned xb_add(unsigned* p, unsigned v) { return __hip_atomic_fetch_add(p, v, __ATOMIC_RELAXED, __HIP_MEMORY_SCOPE_AGENT); }
__device__ __forceinline__ unsigned xb_xcc_id() { return (unsigned)__builtin_amdgcn_s_getreg((3 << 11) | 20) & 0xFu; }
#define XB_SPIN(cond, bar) do { unsigned _sp = 0; while (cond) { __builtin_amdgcn_s_sleep(1); \
    if ((++_sp & 255u) == 0u) { if (xb_ld(&(bar)[XB_TMO])) break; if (_sp > XB_SPIN_CAP) { atomicAdd(&(bar)[XB_TMO], 1u); break; } } } } while (0)
struct XcdBarrier { unsigned* bar; unsigned x; volatile LAS unsigned* st; };
__device__ __forceinline__ XcdBarrier xcd_barrier_post(unsigned* bar, volatile LAS unsigned* st) {
    XcdBarrier b; b.bar = bar; b.x = xb_xcc_id(); b.st = st;
    if (threadIdx.x == 0) (void)xb_add(&bar[XB_XCNT(b.x)], 1u);
    return b;
}
__device__ __forceinline__ void xcd_barrier_complete(unsigned* bar, unsigned x, unsigned& nloc, unsigned& nx) {
    const unsigned G = gridDim.x * gridDim.y * gridDim.z;
    unsigned sum, cnt, mine, sp = 0u;
    for (;;) {
        sum = 0u; cnt = 0u; mine = 0u;
#pragma unroll
        for (unsigned j = 0; j < 16; ++j) { const unsigned c = xb_ld(&bar[XB_XCNT(j)]); sum += c; cnt += (c > 0u) ? 1u : 0u; mine = (j == x) ? c : mine; }
        if (sum == G) break;
        __builtin_amdgcn_s_sleep(1);
        if ((++sp & 255u) == 0u) { if (xb_ld(&bar[XB_TMO])) break; if (sp > XB_SPIN_CAP) { atomicAdd(&bar[XB_TMO], 1u); break; } }
    }
    nloc = mine > 0u ? mine : 1u; nx = cnt > 0u ? cnt : 1u;
}
__device__ __forceinline__ void xcd_barrier(const XcdBarrier& b) {
    asm volatile("s_waitcnt vmcnt(0)" ::: "memory");
    __syncthreads();
    if (threadIdx.x == 0) {
        unsigned* bar = b.bar;
        __builtin_amdgcn_s_waitcnt(0);
        unsigned nloc = b.st[0], nx = b.st[1];
        if (nloc == 0u) { xcd_barrier_complete(bar, b.x, nloc, nx); b.st[0] = nloc; b.st[1] = nx; }
        const unsigned old = xb_add(&bar[XB_XSUB(b.x)], 1u);
        const unsigned gen = old / nloc;
        if (old + 1u == (gen + 1u) * nloc) {
            __builtin_amdgcn_fence(__ATOMIC_RELEASE, "agent");
            asm volatile("s_waitcnt vmcnt(0)" ::: "memory");
            const unsigned og = xb_add(&bar[XB_TOP], 1u);
            const unsigned tg = og / nx;
            if (og + 1u == (tg + 1u) * nx) xb_add(&bar[XB_TOPGEN], 1u);
            else XB_SPIN(xb_ld(&bar[XB_TOPGEN]) == tg, bar);
            __builtin_amdgcn_fence(__ATOMIC_ACQUIRE, "agent");
            xb_add(&bar[XB_XGEN(b.x)], 1u);
            asm volatile("s_waitcnt vmcnt(0)" ::: "memory");
        } else {
            XB_SPIN(xb_ld(&bar[XB_XGEN(b.x)]) == gen, bar);
            __builtin_amdgcn_fence(__ATOMIC_ACQUIRE, "agent");
            asm volatile("s_waitcnt vmcnt(0)" ::: "memory");
        }
    }
    __syncthreads();
}

__global__ void __launch_bounds__(512, 2) mega(Params p_arg) {
    extern __shared__ __attribute__((aligned(16))) unsigned char lds_raw[];
    LAS unsigned char* lds = (LAS unsigned char*)lds_raw;
    cg::grid_group grid = cg::this_grid();
    volatile LAS unsigned* MISC = (volatile LAS unsigned*)(lds + LDS_BYTES - 64);
    if (threadIdx.x < 16) MISC[threadIdx.x] = 0u;
    __syncthreads();
    XcdBarrier xbar = xcd_barrier_post((unsigned*)(p_arg.ws + WS_CTL), MISC);
    const int ph_lo = p_arg.ph_lo, ph_hi = p_arg.ph_hi;
    for (int ph = ph_lo; ph < ph_hi; ++ph) {
        typedef __attribute__((address_space(4))) const Params* cparams_t;
        cparams_t pp = (cparams_t)__builtin_amdgcn_kernarg_segment_ptr(); asm volatile("" : "+s"(pp));
#if defined(__HIP_DEVICE_COMPILE__)
        const Params p = *pp;
#else
        const Params p = p_arg;
#endif
        bf16_t* HB = (bf16_t*)(p.ws + WS_HB); bf16_t* BIG = (bf16_t*)(p.ws + WS_BIG);
        const float* cosT = (const float*)(p.ws + WS_COS); const float* sinT = (const float*)(p.ws + WS_SIN);
        if (ph == 0) {
#ifndef SK_PREP
            prep_phase(lds, p);
#endif
            norm_phase<false>(p.x, p.ffn1_norm, HB, nullptr);
        } else {
            const int l = (ph - 1) / 12, s = (ph - 1) % 12;
            if (s == 2 || s == 8 || s == 11) continue;
            const unsigned char* wl = p.ws + WS_W + (size_t)l * LW_BYTES;
            bf16_t* HB2 = (bf16_t*)(p.ws + WS_HB2);
            pg8::StaticOrder S;
            if (s == 0 || s == 9) {
                pg8::Gemm g{s == 0 ? HB : HB2, (const bf16_t*)(wl + (s == 0 ? LW_GU1 : LW_GU2)), M, NGU, D}; S.init(M, NGU, GSZ(), BID());
#ifndef SK_G1
                pg8::EpiSwiglu E{BIG}; pg8::gemm_phase(lds, g, S, E);
#endif
            } else if (s == 1 || s == 10 || s == 7) {
                const int inst = 3 * l + (s == 1 ? 0 : (s == 7 ? 1 : 2));
                float* slots = (float*)(p.ws + WS_SLOT) + (size_t)inst * M * 32;
                unsigned* cnt = (unsigned*)(p.ws + WS_CTL) + 4096 + inst * 4096;
                pg8::PanelOrder PO{BID()};
                pg8::Gemm g;
                if (s == 7) g = pg8::Gemm{HB, (const bf16_t*)(wl + LW_WO), M, D, D};
                else g = pg8::Gemm{BIG, (const bf16_t*)(wl + (s == 1 ? LW_D1 : LW_D2)), M, D, FF};
#ifndef SK_G2
                if (s == 10 && l + 1 == DEPTH) {
                    pg8::EpiResNorm<true> E{p.out, p.out, 0.5f, p.final_norm, nullptr, slots, cnt}; pg8::gemm_phase(lds, g, PO, E);
                } else {
                    pg8::EpiResNorm<false> E;
                    if (s == 1) E = pg8::EpiResNorm<false>{l == 0 ? p.x : p.out, p.out, 0.5f, p.mix_norm + l * D, HB, slots, cnt};
                    else if (s == 7) E = pg8::EpiResNorm<false>{p.out, p.out, 1.0f, p.ffn2_norm + l * D, HB2, slots, cnt};
                    else E = pg8::EpiResNorm<false>{p.out, p.out, 0.5f, p.ffn1_norm + (l + 1) * D, HB, slots, cnt};
                    pg8::gemm_phase(lds, g, PO, E);
                }
#endif
            } else if (s == 3) {
                pg8::Gemm g{HB, (const bf16_t*)(wl + LW_IN), M, INC, D}; S.init(M, INC, GSZ(), BID());
#ifndef SK_G3
                pg8::EpiInProj E{BIG, cosT, sinT}; pg8::gemm_phase(lds, g, S, E);
#endif
            } else if (s == 4) {
#ifndef SK_ATT
                attn_phase(lds, p, l);
#endif
#ifndef SK_H1
                hgrn_p1(lds, p, l);
#endif
            } else if (s == 5) {
#ifndef SK_H2
                hgrn_p2(p);
#endif
            } else if (s == 6) {
#ifndef SK_H3
                hgrn_p3(lds, p, l);
#endif
            }
        }
        if (ph + 1 < ph_hi) { if (ph == ph_lo) grid.sync(); else { xbar.bar = (unsigned*)(p.ws + WS_CTL); xcd_barrier(xbar); } }
    }
}

extern "C" void kernel_launch(void* const* d_in, const int* in_sizes, int n_in, void* d_out, int out_size, void* d_ws, size_t ws_size, hipStream_t stream) {
    static int grid = 0;
    if (grid == 0) {
        if (n_in != 20 || out_size != M * D || ws_size < WS_END) { fprintf(stderr, "kernel_launch: unexpected shapes (n_in %d out %d ws %zu need %zu)\n", n_in, out_size, ws_size, (size_t)WS_END); grid = -1; return; }
        int dev = 0, cus = 0, per_cu = 0;
        hipGetDevice(&dev);
        hipDeviceGetAttribute(&cus, hipDeviceAttributeMultiprocessorCount, dev);
        if (hipFuncSetAttribute((const void*)mega, hipFuncAttributeMaxDynamicSharedMemorySize, LDS_BYTES) != hipSuccess) { fprintf(stderr, "kernel_launch: hipFuncSetAttribute failed\n"); grid = -1; return; }
        if (hipOccupancyMaxActiveBlocksPerMultiprocessor(&per_cu, (const void*)mega, 512, LDS_BYTES) != hipSuccess || per_cu < 1) { fprintf(stderr, "kernel_launch: occupancy query says %d\n", per_cu); per_cu = 1; }
        (void)hipGetLastError();
        grid = cus * 1;
        if (grid != 256) { fprintf(stderr, "kernel_launch: this build needs a 256-CU device (got %d)\n", cus); grid = -1; return; }
        fprintf(stderr, "kernel_launch: cus %d per_cu %d grid %d\n", cus, per_cu, grid);
    }
    if (grid < 0) return;
    Params p{};
    p.x = (const float*)d_in[0]; p.ffn1_norm = (const float*)d_in[1]; p.ffn1_wg = (const float*)d_in[2]; p.ffn1_wu = (const float*)d_in[3]; p.ffn1_wd = (const float*)d_in[4];
    p.mix_norm = (const float*)d_in[5]; p.w_in = (const float*)d_in[6]; p.w_out = (const float*)d_in[7];
    p.lq1 = (const float*)d_in[8]; p.lk1 = (const float*)d_in[9]; p.lq2 = (const float*)d_in[10]; p.lk2 = (const float*)d_in[11];
    p.subln = (const float*)d_in[12]; p.hlb = (const float*)d_in[13]; p.gnorm = (const float*)d_in[14];
    p.ffn2_norm = (const float*)d_in[15]; p.ffn2_wg = (const float*)d_in[16]; p.ffn2_wu = (const float*)d_in[17]; p.ffn2_wd = (const float*)d_in[18]; p.final_norm = (const float*)d_in[19];
    p.out = (float*)d_out; p.ws = (unsigned char*)d_ws;
    if (hipMemsetAsync((char*)d_ws + WS_CTL, 0, CTL_BYTES, stream) != hipSuccess) { fprintf(stderr, "kernel_launch: memset failed\n"); return; }
    p.ph_lo = 0; p.ph_hi = NPHASE;
    void* args[] = {&p};
    hipError_t e = hipLaunchCooperativeKernel((const void*)mega, dim3(grid), dim3(512), args, LDS_BYTES, stream);
    if (e != hipSuccess) fprintf(stderr, "kernel_launch: cooperative launch failed: %s (grid %d)\n", hipGetErrorString(e), grid);
}
```

```cpp
#include <hip/hip_runtime.h>
#include <hip/hip_cooperative_groups.h>
#include <cstdio>
#include <cstdint>
namespace cg = cooperative_groups;


#define LAS __attribute__((address_space(3)))
typedef unsigned short bf16_t;
typedef short bf16x8 __attribute__((ext_vector_type(8)));
typedef short s16x4 __attribute__((ext_vector_type(4)));
typedef short v4i16_t __attribute__((ext_vector_type(4)));
typedef float f32x2 __attribute__((ext_vector_type(2)));
typedef float f32x4 __attribute__((ext_vector_type(4)));
typedef float f32x16 __attribute__((ext_vector_type(16)));
typedef unsigned u32x2 __attribute__((ext_vector_type(2)));
typedef unsigned u32x4 __attribute__((ext_vector_type(4)));
typedef __bf16 bf16x2_t __attribute__((ext_vector_type(2)));

constexpr int SEQ = 8192, BATCH = 2, M = BATCH * SEQ, D = 2048, FF = 5504, NGU = 2 * FF, INC = 7168, DEPTH = 2;
constexpr int COL_AQ = 0, COL_AK = 1024, COL_AV = 2048, COL_RQ = 3072, COL_RF = 4096, COL_RI = 5120, COL_RG = 6144;
constexpr float NORM_EPS = 1e-6f;
constexpr int LDS_BYTES = 147456;
constexpr int NPHASE = 1 + 12 * DEPTH;

constexpr size_t SZ_GU = (size_t)NGU * D * 2, SZ_DN = (size_t)D * FF * 2, SZ_IN = (size_t)INC * D * 2, SZ_WO = (size_t)D * D * 2;
constexpr size_t LW_GU1 = 0, LW_D1 = LW_GU1 + SZ_GU, LW_IN = LW_D1 + SZ_DN, LW_WO = LW_IN + SZ_IN, LW_GU2 = LW_WO + SZ_WO, LW_D2 = LW_GU2 + SZ_GU, LW_BYTES = LW_D2 + SZ_DN;
constexpr size_t WS_W = 0, WS_HB = WS_W + DEPTH * LW_BYTES, WS_BIG = WS_HB + (size_t)M * D * 2, WS_HST = WS_BIG + (size_t)M * INC * 2,
                 WS_HDEC = WS_HST + (size_t)2048 * 16384 * 2, WS_COS = WS_HDEC + (size_t)2048 * 128 * 4, WS_SIN = WS_COS + (size_t)SEQ * 32 * 4, WS_CTL = WS_SIN + (size_t)SEQ * 32 * 4, CTL_BYTES = 131072, WS_SLOT = WS_CTL + CTL_BYTES, WS_HB2 = WS_SLOT + (size_t)6 * M * 32 * 4, WS_END = WS_HB2 + (size_t)M * D * 2;

struct Params {
    const float* x; const float* ffn1_norm; const float* ffn1_wg; const float* ffn1_wu; const float* ffn1_wd;
    const float* mix_norm; const float* w_in; const float* w_out;
    const float* lq1; const float* lk1; const float* lq2; const float* lk2; const float* subln; const float* hlb; const float* gnorm;
    const float* ffn2_norm; const float* ffn2_wg; const float* ffn2_wu; const float* ffn2_wd; const float* final_norm;
    float* out; unsigned char* ws; int ph_lo; int ph_hi;
};

__device__ __forceinline__ unsigned f2bf(float f) { unsigned u = __builtin_bit_cast(unsigned, f); return (u + 0x7fffu + ((u >> 16) & 1u)) >> 16; }
__device__ __forceinline__ unsigned pk2(float lo, float hi) { f32x2 v = {lo, hi}; bf16x2_t b = __builtin_convertvector(v, bf16x2_t); return __builtin_bit_cast(unsigned, b); }
__device__ __forceinline__ float bf2f(bf16_t b) { return __builtin_bit_cast(float, ((unsigned)b) << 16); }
__device__ __forceinline__ float bflo(unsigned w) { return __builtin_bit_cast(float, w << 16); }
__device__ __forceinline__ float bfhi(unsigned w) { return __builtin_bit_cast(float, w & 0xffff0000u); }
__device__ __forceinline__ float wave_sum(float v) {
#pragma unroll
    for (int o = 1; o < 64; o <<= 1) v += __shfl_xor(v, o);
    return v;
}
__device__ __forceinline__ int BID() { int b = blockIdx.x; asm volatile("" : "+s"(b)); return b; }
__device__ __forceinline__ int GSZ() { int g = gridDim.x; asm volatile("" : "+s"(g)); return g; }
__device__ __forceinline__ float fexp(float x) { return __builtin_amdgcn_exp2f(x * 1.4426950408889634f); }
__device__ __forceinline__ float flog(float x) { return __builtin_amdgcn_logf(x) * 0.6931471805599453f; }
__device__ __forceinline__ float frcp(float x) { return __builtin_amdgcn_rcpf(x); }
__device__ __forceinline__ float sigmoidf_(float x) { return frcp(1.0f + fexp(-x)); }
__device__ __forceinline__ float siluf_(float x) { return x * sigmoidf_(x); }
__host__ __device__ __forceinline__ int perm32(int rho) { const int n = rho >> 4, i = rho & 15; return 8 * (i >> 2) + 4 * n + (i & 3); }
__device__ __forceinline__ float max3f(float a, float b, float c) { float r; asm("v_max3_f32 %0, %1, %2, %3" : "=v"(r) : "v"(a), "v"(b), "v"(c)); return r; }
__device__ __forceinline__ void swap16(unsigned& a, unsigned& b) { auto r = __builtin_amdgcn_permlane16_swap(a, b, false, false); a = r[0]; b = r[1]; }
__device__ __forceinline__ void swap32(unsigned& a, unsigned& b) { auto r = __builtin_amdgcn_permlane32_swap(a, b, false, false); a = r[0]; b = r[1]; }
__device__ __forceinline__ int crow(int r, int hi) { return (r & 3) + 8 * (r >> 2) + 4 * hi; }
__device__ __forceinline__ unsigned off_b(unsigned row, unsigned ch) { return 256u * row + 16u * (ch ^ (((row & 3) << 2) | ((row >> 2) & 3))); }
__device__ __forceinline__ s16x4 vtr(LAS const unsigned char* p) { return __builtin_bit_cast(s16x4, __builtin_amdgcn_ds_read_tr16_b64_v4i16((LAS v4i16_t*)p)); }
__device__ __forceinline__ bf16x8 cat8(s16x4 a, s16x4 b) { return (bf16x8){a[0], a[1], a[2], a[3], b[0], b[1], b[2], b[3]}; }

namespace pg8 {
constexpr int BM = 256, BK = 64, HALF = 128, HTB = HALF * BK * 2, STAGE_BYTES = 8 * HTB, NXCD = 8, WGM = 8;
__host__ __device__ __forceinline__ int lds_byte(int r, int c) { const int st = (r >> 4) * 2 + (c >> 5), rr = r & 15, cc = c & 31, ob = rr * 64 + cc * 2; return st * 1024 + (ob ^ (((ob >> 9) & 1) << 5)); }
__host__ __device__ __forceinline__ void stage_rc(int b, int& R, int& C) { const int st = b / 1024, sb = b % 1024, swz = sb ^ (((sb >> 9) & 1) << 5); R = (st >> 1) * 16 + swz / 64; C = (st & 1) * 32 + (swz % 64) / 2; }
struct Unit { int pm, pn; };
struct Gemm { const bf16_t* A; const bf16_t* Bt; int M, N, K; };
struct StaticOrder {
    int nM, nN, nwg, G, c;
    __device__ void init(int M_, int N_, int G_, int c_) { nM = M_ / BM; nN = N_ / BM; nwg = nM * nN; G = G_; c = c_; }
    __device__ bool next(int i, Unit& u) const {
        const long L = (long)i * G + c; if (L >= nwg) return false;
        int wgid = (int)L; { const int q = nwg / NXCD, r = nwg % NXCD, xcd = wgid % NXCD, off = wgid / NXCD; wgid = (xcd < r ? xcd * (q + 1) : r * (q + 1) + (xcd - r) * q) + off; }
        const int nig = WGM * nN, gid = wgid / nig, fm = gid * WGM, gsz = (nM - fm) < WGM ? (nM - fm) : WGM;
        u.pm = fm + ((wgid % nig) % gsz); u.pn = (wgid % nig) / gsz; return true;
    }
};
struct PanelOrder {
    int c;
    __device__ bool next(int i, Unit& u) const { if (i >= 2) return false; const int x = c & 7, j = c >> 3; u.pm = 32 * i + 4 * x + (j >> 3); u.pn = j & 7; return true; }
};
template <class Epi, class Sched>
__device__ __forceinline__ void gemm_phase(LAS unsigned char* lds, const Gemm g, const Sched& S, const Epi& E) {
    int tid_ = threadIdx.x; asm volatile("" : "+v"(tid_));
    const int tid = tid_, wid = __builtin_amdgcn_readfirstlane(tid >> 6), lane = tid & 63, wr = wid >> 2, wc = wid & 3, fr = lane & 15, fq = lane >> 4;
    const int K = g.K, nt = K / BK;
    unsigned voffA[2];
#pragma unroll
    for (int i = 0; i < 2; ++i) { int R, C; stage_rc(tid * 16 + i * 8192, R, C); voffA[i] = (unsigned)(R * K + C) * 2u; }
    const size_t kstep = (size_t)(BK * 2);
    const size_t hstep = (size_t)HALF * K * 2;
    const size_t tstep = 2 * hstep;
    const unsigned ldsw = (unsigned)wid * 1024u;
    const int aoff = lds_byte(wr * 64 + fr, fq * 8), boff = lds_byte(wc * 32 + fr, fq * 8);
#define PG8_SA(b, h) (((b) * 2 + (h)) * HTB)
#define PG8_SB(b, h) ((4 + (b) * 2 + (h)) * HTB)
#define PG8_STAGE(bufoff, gbase) do { _Pragma("unroll") for (int _i = 0; _i < 2; ++_i) \
        __builtin_amdgcn_global_load_lds((const unsigned*)((const char*)(gbase) + voffA[_i]), (LAS unsigned*)(lds + (bufoff) + ldsw + _i * 8192), 16, 0, 0); } while (0)
#define PG8_LDA(dst, b, h) do { _Pragma("unroll") for (int m = 0; m < 4; ++m) _Pragma("unroll") for (int k = 0; k < 2; ++k) dst[m][k] = *(const LAS bf16x8*)(lds + PG8_SA(b, h) + aoff + m * 2048 + k * 1024); } while (0)
#define PG8_LDB(dst, b, h) do { _Pragma("unroll") for (int n = 0; n < 2; ++n) _Pragma("unroll") for (int k = 0; k < 2; ++k) dst[n][k] = *(const LAS bf16x8*)(lds + PG8_SB(b, h) + boff + n * 2048 + k * 1024); } while (0)
#define PG8_MMA(ai, bj, At, Bt) do { __builtin_amdgcn_s_setprio(1); _Pragma("unroll") for (int m = 0; m < 4; ++m) _Pragma("unroll") for (int n = 0; n < 2; ++n) _Pragma("unroll") for (int k = 0; k < 2; ++k) \
        acc[ai][bj][m][n] = __builtin_amdgcn_mfma_f32_16x16x32_bf16(Bt[n][k], At[m][k], acc[ai][bj][m][n], 0, 0, 0); __builtin_amdgcn_s_setprio(0); } while (0)
#define PG8_WAIT_V(n) asm volatile("s_waitcnt vmcnt(" #n ")" ::: "memory")
#define PG8_WAIT_L(n) asm volatile("s_waitcnt lgkmcnt(" #n ")" ::: "memory")
#define PG8_BAR __builtin_amdgcn_s_barrier()
#define PG8_SCHED __builtin_amdgcn_sched_barrier(0)
    Unit cur, nxt; int ui = 0;
    if (!S.next(0, cur)) return;
    f32x4 acc[2][2][4][2];
#pragma unroll
    for (int a = 0; a < 2; ++a)
#pragma unroll
        for (int b = 0; b < 2; ++b)
#pragma unroll
            for (int m = 0; m < 4; ++m)
#pragma unroll
                for (int n = 0; n < 2; ++n) acc[a][b][m][n] = (f32x4){0.f, 0.f, 0.f, 0.f};
    bf16x8 At[4][2], B0[2][2], B1[2][2];
    const char* cA = (const char*)g.A + (size_t)cur.pm * tstep; const char* cB = (const char*)g.Bt + (size_t)cur.pn * tstep;
    PG8_STAGE(PG8_SB(0, 0), cB); PG8_STAGE(PG8_SB(0, 1), cB + hstep); PG8_STAGE(PG8_SA(0, 0), cA); PG8_STAGE(PG8_SA(0, 1), cA + hstep);
    if (wr == 1) PG8_BAR;
    PG8_WAIT_V(2); PG8_BAR;
    PG8_STAGE(PG8_SB(1, 0), cB + kstep); PG8_STAGE(PG8_SA(1, 0), cA + kstep); PG8_STAGE(PG8_SB(1, 1), cB + hstep + kstep);
    PG8_WAIT_V(6); PG8_BAR;
    for (;;) {
        const bool has_next = S.next(ui + 1, nxt);
        const char* nA = has_next ? (const char*)g.A + (size_t)nxt.pm * tstep : cA; const char* nB = has_next ? (const char*)g.Bt + (size_t)nxt.pn * tstep : cB;
        for (int t = 0; t < nt; t += 2) {
            const bool last = (t == nt - 2);
            const char* a1 = cA + (size_t)(t + 1) * kstep;
            const char* a2 = last ? nA : cA + (size_t)(t + 2) * kstep; const char* b2 = last ? nB : cB + (size_t)(t + 2) * kstep;
            const char* a3 = a2 + kstep; const char* b3 = b2 + kstep;
            PG8_LDB(B0, 0, 0); PG8_LDB(B1, 0, 1); PG8_SCHED; PG8_LDA(At, 0, 0); PG8_STAGE(PG8_SA(1, 1), a1 + hstep);
            PG8_WAIT_V(8); PG8_WAIT_L(0); PG8_BAR; PG8_MMA(0, 0, At, B0); PG8_MMA(0, 1, At, B1); PG8_BAR; PG8_SCHED;
            PG8_LDA(At, 0, 1); PG8_STAGE(PG8_SB(0, 0), b2); PG8_STAGE(PG8_SB(0, 1), b2 + hstep); PG8_STAGE(PG8_SA(0, 0), a2);
            PG8_WAIT_V(8); PG8_WAIT_L(0); PG8_BAR; PG8_MMA(1, 0, At, B0); PG8_MMA(1, 1, At, B1); PG8_BAR; PG8_SCHED;
            PG8_LDB(B0, 1, 0); PG8_LDB(B1, 1, 1); PG8_SCHED; PG8_LDA(At, 1, 0); PG8_STAGE(PG8_SA(0, 1), a2 + hstep);
            PG8_WAIT_V(8); PG8_WAIT_L(0); PG8_BAR; PG8_MMA(0, 0, At, B0); PG8_MMA(0, 1, At, B1); PG8_BAR; PG8_SCHED;
            PG8_LDA(At, 1, 1); PG8_STAGE(PG8_SB(1, 0), b3); PG8_STAGE(PG8_SB(1, 1), b3 + hstep); PG8_STAGE(PG8_SA(1, 0), a3);
            PG8_WAIT_V(8); PG8_WAIT_L(0); PG8_BAR; PG8_MMA(1, 0, At, B0); PG8_MMA(1, 1, At, B1); PG8_BAR; PG8_SCHED;
        }
        if (wr == 0) PG8_BAR;
        E(acc, cur, wr, wc, fr, fq);
        if (!has_next) break;
#pragma unroll
        for (int a = 0; a < 2; ++a)
#pragma unroll
            for (int b = 0; b < 2; ++b)
#pragma unroll
                for (int m = 0; m < 4; ++m)
#pragma unroll
                    for (int n = 0; n < 2; ++n) acc[a][b][m][n] = (f32x4){0.f, 0.f, 0.f, 0.f};
        cur = nxt; cA = nA; cB = nB; ++ui;
        if (wr == 1) PG8_BAR;
    }
    PG8_WAIT_V(0);
    PG8_BAR;
#undef PG8_SA
#undef PG8_SB
#undef PG8_STAGE
#undef PG8_LDA
#undef PG8_LDB
#undef PG8_MMA
#undef PG8_WAIT_V
#undef PG8_WAIT_L
#undef PG8_BAR
#undef PG8_SCHED
}

struct EpiSwiglu {
    bf16_t* O;
    __device__ __forceinline__ void operator()(const f32x4 (&acc)[2][2][4][2], const Unit& u, int wr, int wc, int fr, int fq) const {
        const int row0 = u.pm * BM + wr * 64 + fr, col0 = u.pn * 128 + wc * 32 + 8 * fq;
#pragma unroll
        for (int ai = 0; ai < 2; ++ai)
#pragma unroll
            for (int m = 0; m < 4; ++m) {
                bf16_t* rowp = O + (size_t)(row0 + ai * HALF + m * 16) * FF + col0;
                const f32x4 g0 = acc[ai][0][m][0], g1 = acc[ai][0][m][1], u0 = acc[ai][1][m][0], u1 = acc[ai][1][m][1];
                f32x4 h0, h1;
#pragma unroll
                for (int j = 0; j < 4; ++j) { h0[j] = siluf_(g0[j]) * u0[j]; h1[j] = siluf_(g1[j]) * u1[j]; }
                u32x4 w; w.x = pk2(h0[0], h0[1]); w.y = pk2(h0[2], h0[3]); w.z = pk2(h1[0], h1[1]); w.w = pk2(h1[2], h1[3]);
                *(u32x4*)rowp = w;
            }
    }
};
struct EpiRes {
    const float* base; float* out; float alpha;
    __device__ __forceinline__ void operator()(const f32x4 (&acc)[2][2][4][2], const Unit& u, int wr, int wc, int fr, int fq) const {
        const int row0 = u.pm * BM + wr * 64 + fr, col0 = u.pn * BM + wc * 32 + 4 * fq;
#pragma unroll
        for (int ai = 0; ai < 2; ++ai) {
            f32x4 b[4][2][2];
#pragma unroll
            for (int m = 0; m < 4; ++m) { const size_t off = (size_t)(row0 + ai * HALF + m * 16) * D + col0;
#pragma unroll
                for (int bj = 0; bj < 2; ++bj)
#pragma unroll
                    for (int n = 0; n < 2; ++n) b[m][bj][n] = *(const f32x4*)(base + off + bj * HALF + n * 16); }
#pragma unroll
            for (int m = 0; m < 4; ++m) { const size_t off = (size_t)(row0 + ai * HALF + m * 16) * D + col0;
#pragma unroll
                for (int bj = 0; bj < 2; ++bj)
#pragma unroll
                    for (int n = 0; n < 2; ++n) *(f32x4*)(out + off + bj * HALF + n * 16) = b[m][bj][n] + alpha * acc[ai][bj][m][n]; }
            asm volatile("" ::: "memory");
        }
    }
};
template <bool FINAL>
struct EpiResNorm {
    const float* base; float* out; float alpha; const float* gain; bf16_t* hb; float* slots; unsigned* cnt;
    __device__ __forceinline__ void operator()(f32x4 (&acc)[2][2][4][2], const Unit& u, int wr, int wc, int fr, int fq) const {
        const int row0 = u.pm * BM + wr * 64 + fr, col0 = u.pn * BM + wc * 32 + 4 * fq;
#pragma unroll
        for (int ai = 0; ai < 2; ++ai)
#pragma unroll
            for (int mp = 0; mp < 2; ++mp) {
                f32x4 b[2][2][2];
#pragma unroll
                for (int mm = 0; mm < 2; ++mm) { const size_t off = (size_t)(row0 + ai * HALF + (2 * mp + mm) * 16) * D + col0;
#pragma unroll
                    for (int bj = 0; bj < 2; ++bj)
#pragma unroll
                        for (int n = 0; n < 2; ++n) b[mm][bj][n] = *(const f32x4*)(base + off + bj * HALF + n * 16); }
#pragma unroll
                for (int mm = 0; mm < 2; ++mm) { const int m = 2 * mp + mm; const int row = row0 + ai * HALF + m * 16; const size_t off = (size_t)row * D + col0;
                    float sq = 0.f;
#pragma unroll
                    for (int bj = 0; bj < 2; ++bj)
#pragma unroll
                        for (int n = 0; n < 2; ++n) { const f32x4 v = b[mm][bj][n] + alpha * acc[ai][bj][m][n]; acc[ai][bj][m][n] = v;
                            if (!FINAL) *(f32x4*)(out + off + bj * HALF + n * 16) = v;
                            sq += (v.x * v.x + v.y * v.y) + (v.z * v.z + v.w * v.w); }
                    sq += __shfl_xor(sq, 16); sq += __shfl_xor(sq, 32);
                    if (fq == 0) __hip_atomic_store((unsigned*)(slots + (size_t)row * 32 + u.pn * 4 + wc), __builtin_bit_cast(unsigned, sq), __ATOMIC_RELAXED, __HIP_MEMORY_SCOPE_AGENT);
                }
                asm volatile("" ::: "memory");
            }
        asm volatile("s_waitcnt vmcnt(0)" ::: "memory");
        if ((threadIdx.x & 63) == 0) __hip_atomic_fetch_add(cnt + 64 * u.pm, 1u, __ATOMIC_RELAXED, __HIP_MEMORY_SCOPE_AGENT);
        if (wr == 0 && wc == 0) {
            unsigned sp = 0u;
            while ((unsigned)__builtin_amdgcn_readfirstlane(__hip_atomic_load(cnt + 64 * u.pm, __ATOMIC_RELAXED, __HIP_MEMORY_SCOPE_AGENT)) < 64u) { __builtin_amdgcn_s_sleep(2); if (++sp > (1u << 21)) break; }
            __builtin_amdgcn_fence(__ATOMIC_ACQUIRE, "agent");
        }
        asm volatile("s_waitcnt vmcnt(0) lgkmcnt(0)" ::: "memory"); __builtin_amdgcn_s_barrier(); asm volatile("" ::: "memory");
        float rs[2][4];
#pragma unroll
        for (int ai = 0; ai < 2; ++ai) {
            f32x4 pa[4], pb[4];
#pragma unroll
            for (int m = 0; m < 4; ++m) { const float* sp4 = slots + (size_t)(row0 + ai * HALF + m * 16) * 32 + fq * 8;
                asm volatile("global_load_dwordx4 %0, %1, off sc0 sc1" : "=v"(pa[m]) : "v"(sp4) : "memory");
                asm volatile("global_load_dwordx4 %0, %1, off offset:16 sc0 sc1" : "=v"(pb[m]) : "v"(sp4) : "memory"); }
            asm volatile("s_waitcnt vmcnt(0)" : "+v"(pa[0]), "+v"(pa[1]), "+v"(pa[2]), "+v"(pa[3]), "+v"(pb[0]), "+v"(pb[1]), "+v"(pb[2]), "+v"(pb[3]) :: "memory");
#pragma unroll
            for (int m = 0; m < 4; ++m) {
                float t = ((pa[m].x + pa[m].y) + (pa[m].z + pa[m].w)) + ((pb[m].x + pb[m].y) + (pb[m].z + pb[m].w));
                t += __shfl_xor(t, 16); t += __shfl_xor(t, 32);
                rs[ai][m] = 1.0f / sqrtf(t * (1.0f / D) + NORM_EPS);
            }
            asm volatile("" ::: "memory");
        }
        f32x4 gw[2][2];
#pragma unroll
        for (int bj = 0; bj < 2; ++bj)
#pragma unroll
            for (int n = 0; n < 2; ++n) gw[bj][n] = *(const f32x4*)(gain + col0 + bj * HALF + n * 16);
#pragma unroll
        for (int ai = 0; ai < 2; ++ai)
#pragma unroll
            for (int m = 0; m < 4; ++m) { const size_t off = (size_t)(row0 + ai * HALF + m * 16) * D + col0; const float r = rs[ai][m];
#pragma unroll
                for (int bj = 0; bj < 2; ++bj) {
                    const f32x4 y0 = acc[ai][bj][m][0] * r * gw[bj][0], y1 = acc[ai][bj][m][1] * r * gw[bj][1];
                    if (FINAL) { *(f32x4*)(out + off + bj * HALF) = y0; *(f32x4*)(out + off + bj * HALF + 16) = y1; }
                    else {
                        unsigned a0 = pk2(y0.x, y0.y), a1 = pk2(y0.z, y0.w), b0 = pk2(y1.x, y1.y), b1 = pk2(y1.z, y1.w);
                        swap16(a0, b0); swap16(a1, b1);
                        *(u32x4*)(hb + off + bj * HALF + ((fq & 1) ? 12 : 0)) = (u32x4){a0, a1, b0, b1};
                    }
                }
            }
    }
};
struct EpiInProj {
    bf16_t* P; const float* cosT; const float* sinT;
    __device__ __forceinline__ void operator()(const f32x4 (&acc)[2][2][4][2], const Unit& u, int wr, int wc, int fr, int fq) const {
        const int row0 = u.pm * BM + wr * 64 + fr;
        if (u.pn < 8) {
#pragma unroll
            for (int ai = 0; ai < 2; ++ai)
#pragma unroll
                for (int m = 0; m < 4; ++m) {
                    const int row = row0 + ai * HALF + m * 16, pos = row & (SEQ - 1);
#pragma unroll
                    for (int bj = 0; bj < 2; ++bj) {
                        const int g = 4 * bj + wc, hl = g >> 1, d0 = (g & 1) * 16 + 4 * fq;
                        const f32x4 c = *(const f32x4*)(cosT + pos * 32 + d0), s = *(const f32x4*)(sinT + pos * 32 + d0);
                        const f32x4 x1 = acc[ai][bj][m][0], x2 = acc[ai][bj][m][1];
                        const float qs = (u.pn < 4) ? 0.125f * 1.4426950408889634f : 1.0f;
                        const f32x4 o1 = (x1 * c - x2 * s) * qs, o2 = (x2 * c + x1 * s) * qs;
                        bf16_t* p = P + (size_t)row * INC + u.pn * BM + hl * 64 + d0;
                        unsigned a0 = pk2(o1[0], o1[1]), a1 = pk2(o1[2], o1[3]), b0 = pk2(o2[0], o2[1]), b1 = pk2(o2[2], o2[3]);
                        swap16(a0, b0); swap16(a1, b1);
                        *(u32x4*)(p + ((fq & 1) ? 28 : 0)) = (u32x4){a0, a1, b0, b1};
                        asm volatile("" ::: "memory");
                    }
                }
        } else {
            const int col0 = u.pn * BM + wc * 32 + 8 * fq;
#pragma unroll
            for (int ai = 0; ai < 2; ++ai)
#pragma unroll
                for (int m = 0; m < 4; ++m) {
                    bf16_t* rowp = P + (size_t)(row0 + ai * HALF + m * 16) * INC + col0;
#pragma unroll
                    for (int bj = 0; bj < 2; ++bj) {
                        const f32x4 v0 = acc[ai][bj][m][0], v1 = acc[ai][bj][m][1];
                        u32x4 w; w.x = pk2(v0[0], v0[1]); w.y = pk2(v0[2], v0[3]); w.z = pk2(v1[0], v1[1]); w.w = pk2(v1[2], v1[3]);
                        *(u32x4*)(rowp + bj * HALF) = w;
                    }
                }
        }
    }
};
}

__device__ __forceinline__ int src_col(int type, int np, int& which) {
    which = 0;
    if (type == 0) return np;
    if (type == 1) { const int pn = np >> 8, lr = np & 255, w = lr & 127; which = lr >> 7; return 128 * pn + (w & ~31) + perm32(w & 31); }
    if (np < 2048) { const int p = np & 255, g = p >> 5, n = (p >> 4) & 1, i = p & 15; return (np & ~255) + (g >> 1) * 64 + (g & 1) * 16 + i + 32 * n; }
    return (np & ~31) + perm32(np & 31);
}
__device__ __forceinline__ void transpose_item(const float* W0, const float* W1, int type, int K, int N, bf16_t* WT, LAS float* scr, int item, int lane) {
    const int nblk_total = item;
    (void)nblk_total;
}
__device__ __forceinline__ void transpose_tile(const float* W0, const float* W1, int type, int K, int Nsrc, bf16_t* WT, LAS float* scr, int kb, int nb, int lane) {
    const int k0 = 64 * kb, n0 = 32 * nb;
    int which; const int sc = src_col(type, n0 + (lane & 31), which);
    const float* src = (which ? W1 : W0) + sc;
#pragma unroll 8
    for (int i = 0; i < 32; ++i) { const int kk = 2 * i + (lane >> 5); scr[kk * 33 + (lane & 31)] = __builtin_nontemporal_load(src + (size_t)(k0 + kk) * Nsrc); }
    asm volatile("s_waitcnt lgkmcnt(0)" ::: "memory");
    const int c = lane >> 3;
#pragma unroll
    for (int j = 0; j < 4; ++j) { const int n = (lane & 7) + 8 * j; const LAS float* s = scr + (8 * c) * 33 + n;
        u32x4 o; o.x = pk2(s[0 * 33], s[1 * 33]); o.y = pk2(s[2 * 33], s[3 * 33]); o.z = pk2(s[4 * 33], s[5 * 33]); o.w = pk2(s[6 * 33], s[7 * 33]);
        __builtin_nontemporal_store(o, (u32x4*)(WT + (size_t)(n0 + n) * K + k0 + 8 * c)); }
    asm volatile("s_waitcnt lgkmcnt(0)" ::: "memory");
}
__device__ __forceinline__ void prep_phase(LAS unsigned char* lds, const Params& p) {
    int tid_ = threadIdx.x; asm volatile("" : "+v"(tid_));
    const int tid = tid_, lane = tid & 63, wave = __builtin_amdgcn_readfirstlane(tid >> 6);
    LAS float* scr = (LAS float*)(lds + wave * 16384);
    const int gw = BID() * 8 + wave, NGW = GSZ() * 8;
    constexpr int I_GU = (D / 64) * (NGU / 32), I_DN = (FF / 64) * (D / 32), I_IN = (D / 64) * (INC / 32), I_WO = (D / 64) * (D / 32);
    constexpr int I_LAYER = 2 * I_GU + 2 * I_DN + I_IN + I_WO;
    for (int it = gw; it < DEPTH * I_LAYER; it += NGW) {
        const int l = it / I_LAYER; int r = it - l * I_LAYER;
        unsigned char* wl = p.ws + WS_W + (size_t)l * LW_BYTES;
        if (r < I_GU) { const int nblk = NGU / 32; transpose_tile(p.ffn1_wg + (size_t)l * D * FF, p.ffn1_wu + (size_t)l * D * FF, 1, D, FF, (bf16_t*)(wl + LW_GU1), scr, r / nblk, r % nblk, lane); continue; } r -= I_GU;
        if (r < I_DN) { const int nblk = D / 32; transpose_tile(p.ffn1_wd + (size_t)l * FF * D, nullptr, 0, FF, D, (bf16_t*)(wl + LW_D1), scr, r / nblk, r % nblk, lane); continue; } r -= I_DN;
        if (r < I_IN) { const int nblk = INC / 32; transpose_tile(p.w_in + (size_t)l * D * INC, nullptr, 2, D, INC, (bf16_t*)(wl + LW_IN), scr, r / nblk, r % nblk, lane); continue; } r -= I_IN;
        if (r < I_WO) { const int nblk = D / 32; transpose_tile(p.w_out + (size_t)l * D * D, nullptr, 0, D, D, (bf16_t*)(wl + LW_WO), scr, r / nblk, r % nblk, lane); continue; } r -= I_WO;
        if (r < I_GU) { const int nblk = NGU / 32; transpose_tile(p.ffn2_wg + (size_t)l * D * FF, p.ffn2_wu + (size_t)l * D * FF, 1, D, FF, (bf16_t*)(wl + LW_GU2), scr, r / nblk, r % nblk, lane); continue; } r -= I_GU;
        { const int nblk = D / 32; transpose_tile(p.ffn2_wd + (size_t)l * FF * D, nullptr, 0, FF, D, (bf16_t*)(wl + LW_D2), scr, r / nblk, r % nblk, lane); }
    }
    float* cosT = (float*)(p.ws + WS_COS); float* sinT = (float*)(p.ws + WS_SIN);
    for (int i = BID() * 512 + tid; i < SEQ * 32; i += GSZ() * 512) {
        const int pos = i >> 5, d = i & 31;
        const float inv_freq = (float)exp2(-(double)d * (13.287712379549449 / 32.0));
        const float ang = (float)pos * inv_freq;
        double rev = (double)ang * 0.15915494309189535; rev -= rint(rev);
        const float rf = (float)rev;
        cosT[i] = __builtin_amdgcn_cosf(rf); sinT[i] = __builtin_amdgcn_sinf(rf);
    }
}

template <bool FINAL>
__device__ __forceinline__ void norm_phase(const float* x, const float* w, bf16_t* hb, float* outf) {
    int tid_ = threadIdx.x; asm volatile("" : "+v"(tid_));
    const int tid = tid_, lane = tid & 63, wave = tid >> 6;
    const int gw = BID() * 8 + wave, NGW = GSZ() * 8;
    for (int row = gw; row < M; row += NGW) {
        const f32x4* xr = (const f32x4*)(x + (size_t)row * D) + lane;
        f32x4 v[8]; float s = 0.f;
#pragma unroll
        for (int j = 0; j < 8; ++j) { v[j] = xr[64 * j]; s += (v[j].x * v[j].x + v[j].y * v[j].y) + (v[j].z * v[j].z + v[j].w * v[j].w); }
        const float r = 1.0f / sqrtf(wave_sum(s) * (1.0f / D) + NORM_EPS);
#pragma unroll
        for (int j = 0; j < 8; ++j) {
            const f32x4 w4 = ((const f32x4*)w)[lane + 64 * j];
            const f32x4 y = v[j] * r * w4;
            if (FINAL) ((f32x4*)(outf + (size_t)row * D))[lane + 64 * j] = y;
            else { u32x2 o; o.x = pk2(y.x, y.y); o.y = pk2(y.z, y.w); ((u32x2*)(hb + (size_t)row * D))[lane + 64 * j] = o; }
        }
    }
}

constexpr int ATT_K0 = 0, ATT_V0 = 32768, ATT_X = 65536, ATT_XS = 132;
__device__ __forceinline__ void attn_block(LAS unsigned char* lds, const bf16_t* P, bf16_t* mix, int b, int h, int qb, float lam, float outscale, const float* subln) {
    int tid_ = threadIdx.x; asm volatile("" : "+v"(tid_));
    const int tid = tid_, lane = tid & 63, wave = __builtin_amdgcn_readfirstlane(tid >> 6), r32 = lane & 31, hi = lane >> 5;
    const int comp = wave >> 2, wq = wave & 3;
    const int rb = b * SEQ, q0 = qb * 128, qw0 = q0 + wq * 32, qrow = qw0 + r32;
    const float C1 = 0.125f * 1.4426950408889634f;
    bf16x8 qf[4];
    { const bf16_t* qp = P + (size_t)(rb + qrow) * INC + COL_AQ + h * 128 + comp * 64 + hi * 8;
#pragma unroll
      for (int ks = 0; ks < 4; ++ks) qf[ks] = *(const bf16x8*)(qp + 16 * ks); }
    const int ntiles = 2 * qb + 2;
    const int srow = tid >> 4, sch = tid & 15;
    const bf16_t* kg = P + (size_t)rb * INC + COL_AK + h * 128 + sch * 8;
    const bf16_t* vg = P + (size_t)rb * INC + COL_AV + h * 128 + sch * 8;
    const unsigned so0 = off_b(srow, sch), so1 = off_b(srow + 32, sch);
    u32x4 kr0, kr1, vr0, vr1;
    kr0 = *(const u32x4*)(kg + (size_t)srow * INC); kr1 = *(const u32x4*)(kg + (size_t)(srow + 32) * INC);
    vr0 = *(const u32x4*)(vg + (size_t)srow * INC); vr1 = *(const u32x4*)(vg + (size_t)(srow + 32) * INC);
    *(LAS u32x4*)(lds + ATT_K0 + so0) = kr0; *(LAS u32x4*)(lds + ATT_K0 + so1) = kr1;
    *(LAS u32x4*)(lds + ATT_V0 + so0) = vr0; *(LAS u32x4*)(lds + ATT_V0 + so1) = vr1;
    float mrun = -INFINITY, lrun = 0.f;
    f32x16 o[4];
#pragma unroll
    for (int c = 0; c < 4; ++c)
#pragma unroll
        for (int j = 0; j < 16; ++j) o[c][j] = 0.f;
    const int blk = (lane >> 4) & 1, qq = (lane & 15) >> 2, pp = lane & 3;
    unsigned kbase[4], vbase[4][2];
#pragma unroll
    for (int ks = 0; ks < 4; ++ks) kbase[ks] = off_b(r32, comp * 8 + 2 * ks + hi);
#pragma unroll
    for (int c = 0; c < 4; ++c)
#pragma unroll
        for (int t = 0; t < 2; ++t) vbase[c][t] = off_b(8 * t + 4 * hi + qq, 4 * c + 2 * blk + (pp >> 1)) + 8 * (pp & 1);
    asm volatile("" :: "v"(qf[0]), "v"(qf[1]), "v"(qf[2]), "v"(qf[3]));
    for (int kt = 0; kt < ntiles; ++kt) {
        __syncthreads();
        const int buf = kt & 1;
        if (kt + 1 < ntiles) {
            const size_t ro = (size_t)(64 * (kt + 1)) * INC;
            kr0 = *(const u32x4*)(kg + ro + (size_t)srow * INC); kr1 = *(const u32x4*)(kg + ro + (size_t)(srow + 32) * INC);
            vr0 = *(const u32x4*)(vg + ro + (size_t)srow * INC); vr1 = *(const u32x4*)(vg + ro + (size_t)(srow + 32) * INC);
        }
        const int kb = 64 * kt;
        if (kb <= qw0 + 31) {
            LAS const unsigned char* Kb = lds + ATT_K0 + buf * 16384;
            LAS const unsigned char* Vb = lds + ATT_V0 + buf * 16384;
            f32x16 s0, s1;
#pragma unroll
            for (int j = 0; j < 16; ++j) { s0[j] = 0.f; s1[j] = 0.f; }
            bf16x8 ka[4][2];
#pragma unroll
            for (int ks = 0; ks < 4; ++ks) { ka[ks][0] = *(const LAS bf16x8*)(Kb + kbase[ks]); ka[ks][1] = *(const LAS bf16x8*)(Kb + kbase[ks] + 8192); }
            __builtin_amdgcn_sched_barrier(0);
#pragma unroll
            for (int ks = 0; ks < 4; ++ks) {
                s0 = __builtin_amdgcn_mfma_f32_32x32x16_bf16(ka[ks][0], qf[ks], s0, 0, 0, 0);
                s1 = __builtin_amdgcn_mfma_f32_32x32x16_bf16(ka[ks][1], qf[ks], s1, 0, 0, 0);
            }
            if (kb + 63 > qw0) {
#pragma unroll
                for (int j = 0; j < 16; ++j) { const int key = kb + crow(j, hi); if (key > qrow) s0[j] = -INFINITY; if (key + 32 > qrow) s1[j] = -INFINITY; }
            }
            float mxa = max3f(s0[0], s1[0], s0[1]), mxb = max3f(s1[1], s0[2], s1[2]), mxc = max3f(s0[3], s1[3], s0[4]), mxd = max3f(s1[4], s0[5], s1[5]);
            mxa = max3f(mxa, s0[6], s1[6]); mxb = max3f(mxb, s0[7], s1[7]); mxc = max3f(mxc, s0[8], s1[8]); mxd = max3f(mxd, s0[9], s1[9]);
            mxa = max3f(mxa, s0[10], s1[10]); mxb = max3f(mxb, s0[11], s1[11]); mxc = max3f(mxc, s0[12], s1[12]); mxd = max3f(mxd, s0[13], s1[13]);
            mxa = max3f(mxa, s0[14], s1[14]); mxb = max3f(mxb, s0[15], s1[15]);
            float mx = max3f(mxa, mxb, max3f(mxc, mxd, mxd));
            { auto rr = __builtin_amdgcn_permlane32_swap(__builtin_bit_cast(unsigned, mx), __builtin_bit_cast(unsigned, mx), false, false);
              mx = fmaxf(__builtin_bit_cast(float, rr[0]), __builtin_bit_cast(float, rr[1])); }
            if (__any(mx > mrun + 8.0f)) {
                const float mnew = fmaxf(mrun, mx); const float alpha = __builtin_amdgcn_exp2f(mrun - mnew); mrun = mnew; lrun *= alpha;
#pragma unroll
                for (int c = 0; c < 4; ++c)
#pragma unroll
                    for (int j = 0; j < 16; ++j) o[c][j] *= alpha;
            }
#pragma unroll
            for (int j = 0; j < 16; ++j) { s0[j] = __builtin_amdgcn_exp2f(s0[j] - mrun); s1[j] = __builtin_amdgcn_exp2f(s1[j] - mrun); }
            float ps0 = 0.f, ps1 = 0.f, ps2 = 0.f, ps3 = 0.f;
#pragma unroll
            for (int j = 0; j < 16; j += 2) { ps0 += s0[j]; ps1 += s1[j]; ps2 += s0[j + 1]; ps3 += s1[j + 1]; }
            lrun += (ps0 + ps1) + (ps2 + ps3);
            bf16x8 pb[4];
#pragma unroll
            for (int s2 = 0; s2 < 2; ++s2) {
                u32x4 w0, w1;
                w0.x = pk2(s0[8 * s2 + 0], s0[8 * s2 + 1]); w0.y = pk2(s0[8 * s2 + 2], s0[8 * s2 + 3]); w0.z = pk2(s0[8 * s2 + 4], s0[8 * s2 + 5]); w0.w = pk2(s0[8 * s2 + 6], s0[8 * s2 + 7]);
                w1.x = pk2(s1[8 * s2 + 0], s1[8 * s2 + 1]); w1.y = pk2(s1[8 * s2 + 2], s1[8 * s2 + 3]); w1.z = pk2(s1[8 * s2 + 4], s1[8 * s2 + 5]); w1.w = pk2(s1[8 * s2 + 6], s1[8 * s2 + 7]);
                pb[s2] = __builtin_bit_cast(bf16x8, w0); pb[2 + s2] = __builtin_bit_cast(bf16x8, w1);
            }
#pragma unroll
            for (int s = 0; s < 4; ++s) {
#pragma unroll
                for (int c = 0; c < 4; ++c) {
                    const s16x4 v0 = vtr(Vb + vbase[c][0] + 4096 * s);
                    const s16x4 v1 = vtr(Vb + vbase[c][1] + 4096 * s);
                    o[c] = __builtin_amdgcn_mfma_f32_32x32x16_bf16(cat8(v0, v1), pb[s], o[c], 0, 0, 0);
                }
            }
        }
        if (kt + 1 < ntiles) {
            const int nb = (kt + 1) & 1;
            *(LAS u32x4*)(lds + ATT_K0 + nb * 16384 + so0) = kr0; *(LAS u32x4*)(lds + ATT_K0 + nb * 16384 + so1) = kr1;
            *(LAS u32x4*)(lds + ATT_V0 + nb * 16384 + so0) = vr0; *(LAS u32x4*)(lds + ATT_V0 + nb * 16384 + so1) = vr1;
        }
    }
    const float ltot = lrun + __shfl_xor(lrun, 32);
    const float inv = 1.0f / ltot;
    LAS float* X = (LAS float*)(lds + ATT_X) + (wq * 32 + r32) * ATT_XS;
    if (comp == 1) {
        const float sc = lam * inv;
#pragma unroll
        for (int c = 0; c < 4; ++c)
#pragma unroll
            for (int jj = 0; jj < 4; ++jj) { f32x4 v = {o[c][4 * jj] * sc, o[c][4 * jj + 1] * sc, o[c][4 * jj + 2] * sc, o[c][4 * jj + 3] * sc}; *(LAS f32x4*)(X + 32 * c + 8 * jj + 4 * hi) = v; }
    }
    __syncthreads();
    if (comp == 0) {
        float ss = 0.f;
#pragma unroll
        for (int c = 0; c < 4; ++c)
#pragma unroll
            for (int jj = 0; jj < 4; ++jj) {
                const f32x4 x2 = *(const LAS f32x4*)(X + 32 * c + 8 * jj + 4 * hi);
#pragma unroll
                for (int e = 0; e < 4; ++e) { const float v = o[c][4 * jj + e] * inv - x2[e]; o[c][4 * jj + e] = v; ss += v * v; }
            }
        ss += __shfl_xor(ss, 32);
        const float rms = outscale / sqrtf(ss * (1.0f / 128.0f) + NORM_EPS);
        bf16_t* op = mix + (size_t)(rb + qrow) * D + h * 128;
#pragma unroll
        for (int c = 0; c < 4; ++c)
#pragma unroll
            for (int jp = 0; jp < 2; ++jp) {
                const int j0 = 8 * jp, dv0 = 32 * c + 16 * jp + 4 * hi;
                const f32x4 wa = *(const f32x4*)(subln + dv0), wb = *(const f32x4*)(subln + dv0 + 8);
                unsigned a0 = pk2(o[c][j0] * rms * wa[0], o[c][j0 + 1] * rms * wa[1]), a1 = pk2(o[c][j0 + 2] * rms * wa[2], o[c][j0 + 3] * rms * wa[3]);
                unsigned b0 = pk2(o[c][j0 + 4] * rms * wb[0], o[c][j0 + 5] * rms * wb[1]), b1 = pk2(o[c][j0 + 6] * rms * wb[2], o[c][j0 + 7] * rms * wb[3]);
                swap32(a0, b0); swap32(a1, b1);
                *(u32x4*)(op + 32 * c + 16 * jp + (hi ? 8 : 0)) = (u32x4){a0, a1, b0, b1};
            }
    }
}
__device__ __forceinline__ void attn_phase(LAS unsigned char* lds, const Params& p, int layer) {
    const bf16_t* P = (const bf16_t*)(p.ws + WS_BIG); bf16_t* mix = (bf16_t*)(p.ws + WS_HB);
    float d1 = 0.f, d2 = 0.f;
    for (int i = 0; i < 64; ++i) { d1 += p.lq1[layer * 64 + i] * p.lk1[layer * 64 + i]; d2 += p.lq2[layer * 64 + i] * p.lk2[layer * 64 + i]; }
    const float lambda_init = 0.8f - 0.6f * expf(-0.3f * (float)layer);
    const float lam = expf(d1) - expf(d2) + lambda_init;
    const float* subln = p.subln + layer * 128;
    const int nblk = GSZ(), bid = BID();
    for (int it0 = bid; it0 < 512; it0 += nblk) {
        int it = it0;
        if (nblk == 256) { const int x = bid & 7, j = bid >> 3, r = it0 >> 8; it = (2 * x + r) * 32 + j; }
        const int bh = it >> 5, pr = it & 31, b = bh >> 3, h = bh & 7;
        attn_block(lds, P, mix, b, h, pr, lam, 1.0f - lambda_init, subln);
        __syncthreads();
        attn_block(lds, P, mix, b, h, 63 - pr, lam, 1.0f - lambda_init, subln);
        __syncthreads();
    }
}

constexpr int HG_QI = 0, HG_QH = 16384, HG_KH = 32768, HG_V = 49152, HG_ST = 65536, HG_TOT = 98304, HG_OS = 100352, HG_OSS = 132;
__device__ __forceinline__ float hgrn_lb(const Params& p, int layer, int idx) {
    if (layer == 0) return 0.f;
    const float a = p.hlb[idx], b = p.hlb[1024 + idx];
    return 1.0f / (1.0f + expf(a - b));
}
#define HG_LBAR() do { asm volatile("s_waitcnt lgkmcnt(0)" ::: "memory"); __builtin_amdgcn_s_barrier(); asm volatile("" ::: "memory"); } while (0)
__device__ __forceinline__ void hgrn_p1(LAS unsigned char* lds, const Params& p, int layer) {
    int tid_ = threadIdx.x; asm volatile("" : "+v"(tid_));
    const int tid = tid_, lane = tid & 63, wave = __builtin_amdgcn_readfirstlane(tid >> 6), r32 = lane & 31, hi = lane >> 5;
    const bf16_t* P = (const bf16_t*)(p.ws + WS_BIG); bf16_t* HST = (bf16_t*)(p.ws + WS_HST); float* HDEC = (float*)(p.ws + WS_HDEC);
    const int k = tid & 127, seg = tid >> 7;
    LAS float* tot = (LAS float*)(lds + HG_TOT);
    const int blk = (lane >> 4) & 1, qq = (lane & 15) >> 2, pp = lane & 3;
    const int nblk = GSZ();
#define P1_LOAD(item_) do { const int bh_ = (item_) >> 7, c_ = (item_) & 127, b_ = bh_ >> 3, h_ = bh_ & 7; const size_t row0_ = (size_t)b_ * SEQ + 64 * c_; \
        const bf16_t* fp_ = P + (row0_ + 16 * seg) * INC + COL_RF + h_ * 128 + k; \
        _Pragma("unroll") for (int i = 0; i < 16; ++i) fr[i] = fp_[(size_t)i * INC]; \
        _Pragma("unroll") for (int i = 0; i < 2; ++i) { const int idx = tid + 512 * i, row = idx >> 4, ch = idx & 15; vr[i] = *(const u32x4*)(P + (row0_ + row) * INC + COL_RI + h_ * 128 + ch * 8); } \
        lbn = hgrn_lb(p, layer, h_ * 128 + k); } while (0)
    bf16_t fr[16]; u32x4 vr[2]; float lbn = 0.f;
    int item = BID();
    if (item < 2048) P1_LOAD(item);
    for (; item < 2048; item += nblk) {
        const float lb = lbn;
        float bc[16], kk[16]; float run = 0.f;
#pragma unroll
        for (int i = 0; i < 16; ++i) {
            const float fl = bf2f(fr[i]);
            const float sg = sigmoidf_(fl), f = lb + (1.0f - lb) * sg;
            run += flog(f); bc[i] = run; kk[i] = (1.0f - lb) * sigmoidf_(-fl);
        }
        tot[seg * 128 + k] = run;
#pragma unroll
        for (int i = 0; i < 2; ++i) { const int idx = tid + 512 * i, row = idx >> 4, ch = idx & 15; *(LAS u32x4*)(lds + HG_V + off_b(row, ch)) = vr[i]; }
        HG_LBAR();
        float offs = 0.f, blast = 0.f;
#pragma unroll
        for (int s = 0; s < 4; ++s) { const float t = tot[s * 128 + k]; blast += t; if (s < seg) offs += t; }
#pragma unroll
        for (int i = 0; i < 16; ++i) {
            const float kt = kk[i] * fexp(blast - (bc[i] + offs));
            *(LAS bf16_t*)(lds + HG_KH + off_b(16 * seg + i, k >> 3) + (k & 7) * 2) = (bf16_t)f2bf(kt);
        }
        if (seg == 0) HDEC[(size_t)item * 128 + k] = fexp(blast);
        if (item + nblk < 2048) P1_LOAD(item + nblk);
        HG_LBAR();
        const int ktile = wave >> 1, vt0 = 2 * (wave & 1);
        f32x16 acc[2];
#pragma unroll
        for (int j = 0; j < 16; ++j) { acc[0][j] = 0.f; acc[1][j] = 0.f; }
#pragma unroll
        for (int ks = 0; ks < 4; ++ks) {
            const unsigned r0 = 16 * ks + 8 * hi + qq;
            const s16x4 a0 = vtr(lds + HG_KH + off_b(r0, 4 * ktile + 2 * blk + (pp >> 1)) + 8 * (pp & 1));
            const s16x4 a1 = vtr(lds + HG_KH + off_b(r0 + 4, 4 * ktile + 2 * blk + (pp >> 1)) + 8 * (pp & 1));
            const bf16x8 af = cat8(a0, a1);
#pragma unroll
            for (int vi = 0; vi < 2; ++vi) {
                const s16x4 b0 = vtr(lds + HG_V + off_b(r0, 4 * (vt0 + vi) + 2 * blk + (pp >> 1)) + 8 * (pp & 1));
                const s16x4 b1 = vtr(lds + HG_V + off_b(r0 + 4, 4 * (vt0 + vi) + 2 * blk + (pp >> 1)) + 8 * (pp & 1));
                acc[vi] = __builtin_amdgcn_mfma_f32_32x32x16_bf16(af, cat8(b0, b1), acc[vi], 0, 0, 0);
            }
        }
        bf16_t* st = HST + (size_t)item * 16384;
#pragma unroll
        for (int vi = 0; vi < 2; ++vi) {
            const int v = 32 * (vt0 + vi) + r32;
#pragma unroll
            for (int jp = 0; jp < 2; ++jp) {
                const int j0 = 8 * jp;
                unsigned a0 = pk2(acc[vi][j0], acc[vi][j0 + 1]), a1 = pk2(acc[vi][j0 + 2], acc[vi][j0 + 3]), b0 = pk2(acc[vi][j0 + 4], acc[vi][j0 + 5]), b1 = pk2(acc[vi][j0 + 6], acc[vi][j0 + 7]);
                swap32(a0, b0); swap32(a1, b1);
                *(u32x4*)(st + v * 128 + 32 * ktile + 16 * jp + (hi ? 8 : 0)) = (u32x4){a0, a1, b0, b1};
            }
        }
        HG_LBAR();
    }
#undef P1_LOAD
}
__device__ __forceinline__ void hgrn_p2(const Params& p) {
    bf16_t* HST = (bf16_t*)(p.ws + WS_HST); const float* HDEC = (const float*)(p.ws + WS_HDEC);
    const int gid = BID() * 512 + threadIdx.x, nth = GSZ() * 512;
    for (int u = gid; u < 16 * 4096; u += nth) {
        const int bh = u >> 12, e4 = (u & 4095) * 4, k0 = e4 & 127;
        bf16_t* base = HST + (size_t)bh * 128 * 16384 + e4;
        const float* dbase = HDEC + (size_t)bh * 128 * 128 + k0;
        f32x4 st = {0.f, 0.f, 0.f, 0.f};
        for (int c0 = 0; c0 < 128; c0 += 16) {
            u32x2 L[16]; f32x4 dc[16];
#pragma unroll
            for (int i = 0; i < 16; ++i) { L[i] = *(const u32x2*)(base + (size_t)(c0 + i) * 16384); dc[i] = *(const f32x4*)(dbase + (size_t)(c0 + i) * 128); }
#pragma unroll
            for (int i = 0; i < 16; ++i) {
                u32x2 w; w.x = pk2(st[0], st[1]); w.y = pk2(st[2], st[3]);
                *(u32x2*)(base + (size_t)(c0 + i) * 16384) = w;
                st[0] = dc[i][0] * st[0] + bflo(L[i].x); st[1] = dc[i][1] * st[1] + bfhi(L[i].x);
                st[2] = dc[i][2] * st[2] + bflo(L[i].y); st[3] = dc[i][3] * st[3] + bfhi(L[i].y);
            }
        }
    }
}
__device__ __forceinline__ void hgrn_p3(LAS unsigned char* lds, const Params& p, int layer) {
    int tid_ = threadIdx.x; asm volatile("" : "+v"(tid_));
    const int tid = tid_, lane = tid & 63, wave = __builtin_amdgcn_readfirstlane(tid >> 6), r32 = lane & 31, hi = lane >> 5;
    const bf16_t* P = (const bf16_t*)(p.ws + WS_BIG); const bf16_t* HST = (const bf16_t*)(p.ws + WS_HST); bf16_t* mix = (bf16_t*)(p.ws + WS_HB);
    const float* gw = p.gnorm + layer * 128;
    const int k = tid & 127, seg = tid >> 7;
    LAS float* tot = (LAS float*)(lds + HG_TOT);
    LAS float* OS = (LAS float*)(lds + HG_OS);
    const int blk = (lane >> 4) & 1, qq = (lane & 15) >> 2, pp = lane & 3;
    const int nblk = GSZ();
#define P3_LOAD(item_) do { const int bh_ = (item_) >> 7, c_ = (item_) & 127, b_ = bh_ >> 3, h_ = bh_ & 7; const size_t row0_ = (size_t)b_ * SEQ + 64 * c_; \
        const bf16_t* fp_ = P + (row0_ + 16 * seg) * INC + COL_RF + h_ * 128 + k; const bf16_t* qp_ = P + (row0_ + 16 * seg) * INC + COL_RQ + h_ * 128 + k; \
        _Pragma("unroll") for (int i = 0; i < 16; ++i) { fr[i] = fp_[(size_t)i * INC]; qr[i] = qp_[(size_t)i * INC]; } \
        _Pragma("unroll") for (int i = 0; i < 2; ++i) { const int idx = tid + 512 * i, row = idx >> 4, ch = idx & 15; vr[i] = *(const u32x4*)(P + (row0_ + row) * INC + COL_RI + h_ * 128 + ch * 8); } \
        lbn = hgrn_lb(p, layer, h_ * 128 + k); } while (0)
    bf16_t fr[16], qr[16]; u32x4 vr[2]; float lbn = 0.f;
    int item = BID();
    if (item < 2048) P3_LOAD(item);
    for (; item < 2048; item += nblk) {
        const int bh = item >> 7, c = item & 127, b = bh >> 3, h = bh & 7;
        const size_t row0 = (size_t)b * SEQ + 64 * c;
        const float lb = lbn;
        u32x4 str[4];
#pragma unroll
        for (int i = 0; i < 4; ++i) { const int idx = tid + 512 * i, row = idx >> 4, ch = idx & 15; str[i] = *(const u32x4*)(HST + (size_t)item * 16384 + row * 128 + ch * 8); }
        float bc[16], kk[16], qv[16]; float run = 0.f;
#pragma unroll
        for (int i = 0; i < 16; ++i) {
            const float fl = bf2f(fr[i]);
            const float sg = sigmoidf_(fl), f = lb + (1.0f - lb) * sg;
            run += flog(f); bc[i] = run; kk[i] = (1.0f - lb) * sigmoidf_(-fl);
            qv[i] = siluf_(bf2f(qr[i]));
        }
        tot[seg * 128 + k] = run;
#pragma unroll
        for (int i = 0; i < 2; ++i) { const int idx = tid + 512 * i, row = idx >> 4, ch = idx & 15; *(LAS u32x4*)(lds + HG_V + off_b(row, ch)) = vr[i]; }
#pragma unroll
        for (int i = 0; i < 4; ++i) { const int idx = tid + 512 * i, row = idx >> 4, ch = idx & 15; *(LAS u32x4*)(lds + HG_ST + off_b(row, ch)) = str[i]; }
        HG_LBAR();
        float offs = 0.f;
#pragma unroll
        for (int s = 0; s < 4; ++s) { const float t = tot[s * 128 + k]; if (s < seg) offs += t; }
        const float ref = tot[k] + tot[128 + k];
#pragma unroll
        for (int i = 0; i < 16; ++i) {
            const float bt = bc[i] + offs;
            const unsigned a = off_b(16 * seg + i, k >> 3) + (k & 7) * 2;
            *(LAS bf16_t*)(lds + HG_QI + a) = (bf16_t)f2bf(qv[i] * fexp(bt));
            *(LAS bf16_t*)(lds + HG_QH + a) = (bf16_t)f2bf(qv[i] * fexp(fminf(bt - ref, 80.f)));
            *(LAS bf16_t*)(lds + HG_KH + a) = (bf16_t)f2bf(kk[i] * fexp(fminf(ref - bt, 80.f)));
        }
        if (item + nblk < 2048) P3_LOAD(item + nblk);
        const u32x4* gp = (const u32x4*)(P + (row0 + (tid >> 3)) * INC + COL_RG + h * 128 + (tid & 7) * 16);
        const u32x4 g0 = gp[0], g1 = gp[1];
        HG_LBAR();
        const int vt = wave & 3, tt = wave >> 2;
        f32x16 o;
#pragma unroll
        for (int j = 0; j < 16; ++j) o[j] = 0.f;
#pragma unroll
        for (int ks = 0; ks < 8; ++ks) {
            const bf16x8 a = *(const LAS bf16x8*)(lds + HG_ST + off_b(32 * vt + r32, 2 * ks + hi));
            const bf16x8 bq = *(const LAS bf16x8*)(lds + HG_QI + off_b(32 * tt + r32, 2 * ks + hi));
            o = __builtin_amdgcn_mfma_f32_32x32x16_bf16(a, bq, o, 0, 0, 0);
        }
        for (int st = 0; st <= tt; ++st) {
            f32x16 sc;
#pragma unroll
            for (int j = 0; j < 16; ++j) sc[j] = 0.f;
#pragma unroll
            for (int ks = 0; ks < 8; ++ks) {
                const bf16x8 a = *(const LAS bf16x8*)(lds + HG_KH + off_b(32 * st + r32, 2 * ks + hi));
                const bf16x8 bq = *(const LAS bf16x8*)(lds + HG_QH + off_b(32 * tt + r32, 2 * ks + hi));
                sc = __builtin_amdgcn_mfma_f32_32x32x16_bf16(a, bq, sc, 0, 0, 0);
            }
            if (st == tt) {
#pragma unroll
                for (int j = 0; j < 16; ++j) if (crow(j, hi) > r32) sc[j] = 0.f;
            }
#pragma unroll
            for (int s2 = 0; s2 < 2; ++s2) {
                u32x4 w; w.x = pk2(sc[8 * s2 + 0], sc[8 * s2 + 1]); w.y = pk2(sc[8 * s2 + 2], sc[8 * s2 + 3]); w.z = pk2(sc[8 * s2 + 4], sc[8 * s2 + 5]); w.w = pk2(sc[8 * s2 + 6], sc[8 * s2 + 7]);
                const bf16x8 pbv = __builtin_bit_cast(bf16x8, w);
                const unsigned r0 = 32 * st + 16 * s2 + 4 * hi + qq;
                const s16x4 v0 = vtr(lds + HG_V + off_b(r0, 4 * vt + 2 * blk + (pp >> 1)) + 8 * (pp & 1));
                const s16x4 v1 = vtr(lds + HG_V + off_b(r0 + 8, 4 * vt + 2 * blk + (pp >> 1)) + 8 * (pp & 1));
                o = __builtin_amdgcn_mfma_f32_32x32x16_bf16(cat8(v0, v1), pbv, o, 0, 0, 0);
            }
        }
#pragma unroll
        for (int jj = 0; jj < 4; ++jj) { f32x4 v = {o[4 * jj], o[4 * jj + 1], o[4 * jj + 2], o[4 * jj + 3]};
            *(LAS f32x4*)(OS + (32 * tt + r32) * HG_OSS + 32 * vt + 8 * jj + 4 * hi) = v; }
        HG_LBAR();
        {
            const int t = tid >> 3, vs = (tid & 7) * 16;
            f32x4 x[4]; float ss = 0.f;
#pragma unroll
            for (int i = 0; i < 4; ++i) { x[i] = *(const LAS f32x4*)(OS + t * HG_OSS + vs + 4 * i); ss += (x[i].x * x[i].x + x[i].y * x[i].y) + (x[i].z * x[i].z + x[i].w * x[i].w); }
            ss += __shfl_xor(ss, 1); ss += __shfl_xor(ss, 2); ss += __shfl_xor(ss, 4);
            const float rms = 1.0f / sqrtf(ss * (1.0f / 128.0f) + NORM_EPS);
            const unsigned gwd[8] = {g0.x, g0.y, g0.z, g0.w, g1.x, g1.y, g1.z, g1.w};
            unsigned ow[8];
#pragma unroll
            for (int i = 0; i < 8; ++i) {
                const float ga = bflo(gwd[i]), gb = bfhi(gwd[i]);
                const float xa = x[i >> 1][(i & 1) * 2], xb = x[i >> 1][(i & 1) * 2 + 1];
                ow[i] = pk2(xa * rms * gw[vs + 2 * i] * siluf_(ga), xb * rms * gw[vs + 2 * i + 1] * siluf_(gb));
            }
            u32x4* op = (u32x4*)(mix + (row0 + t) * D + 1024 + h * 128 + vs);
            op[0] = (u32x4){ow[0], ow[1], ow[2], ow[3]}; op[1] = (u32x4){ow[4], ow[5], ow[6], ow[7]};
        }
        HG_LBAR();
    }
#undef P3_LOAD
}

#define XB_TMO      128
#define XB_XCNT(j)  (256  + 64 * (j))
#define XB_XSUB(j)  (1280 + 64 * (j))
#define XB_XGEN(j)  (2304 + 64 * (j))
#define XB_TOP      3328
#define XB_TOPGEN   3392
#define XCD_BAR_WORDS 3456
#define XB_SPIN_CAP (1u << 22)
__device__ __forceinline__ unsigned xb_ld(unsigned* p)              { return __hip_atomic_load(p, __ATOMIC_RELAXED, __HIP_MEMORY_SCOPE_AGENT); }
__device__ __forceinline__ unsigned xb_add(unsigned* p, unsigned v) { return __hip_atomic_fetch_add(p, v, __ATOMIC_RELAXED, __HIP_MEMORY_SCOPE_AGENT); }
__device__ __forceinline__ unsigned xb_xcc_id() { return (unsigned)__builtin_amdgcn_s_getreg((3 << 11) | 20) & 0xFu; }
#define XB_SPIN(cond, bar) do { unsigned _sp = 0; while (cond) { __builtin_amdgcn_s_sleep(1); \
    if ((++_sp & 255u) == 0u) { if (xb_ld(&(bar)[XB_TMO])) break; if (_sp > XB_SPIN_CAP) { atomicAdd(&(bar)[XB_TMO], 1u); break; } } } } while (0)
struct XcdBarrier { unsigned* bar; unsigned x; volatile LAS unsigned* st; };
__device__ __forceinline__ XcdBarrier xcd_barrier_post(unsigned* bar, volatile LAS unsigned* st) {
    XcdBarrier b; b.bar = bar; b.x = xb_xcc_id(); b.st = st;
    if (threadIdx.x == 0) (void)xb_add(&bar[XB_XCNT(b.x)], 1u);
    return b;
}
__device__ __forceinline__ void xcd_barrier_complete(unsigned* bar, unsigned x, unsigned& nloc, unsigned& nx) {
    const unsigned G = gridDim.x * gridDim.y * gridDim.z;
    unsigned sum, cnt, mine, sp = 0u;
    for (;;) {
        sum = 0u; cnt = 0u; mine = 0u;
#pragma unroll
        for (unsigned j = 0; j < 16; ++j) { const unsigned c = xb_ld(&bar[XB_XCNT(j)]); sum += c; cnt += (c > 0u) ? 1u : 0u; mine = (j == x) ? c : mine; }
        if (sum == G) break;
        __builtin_amdgcn_s_sleep(1);
        if ((++sp & 255u) == 0u) { if (xb_ld(&bar[XB_TMO])) break; if (sp > XB_SPIN_CAP) { atomicAdd(&bar[XB_TMO], 1u); break; } }
    }
    nloc = mine > 0u ? mine : 1u; nx = cnt > 0u ? cnt : 1u;
}
__device__ __forceinline__ void xcd_barrier(const XcdBarrier& b) {
    asm volatile("s_waitcnt vmcnt(0)" ::: "memory");
    __syncthreads();
    if (threadIdx.x == 0) {
        unsigned* bar = b.bar;
        __builtin_amdgcn_s_waitcnt(0);
        unsigned nloc = b.st[0], nx = b.st[1];
        if (nloc == 0u) { xcd_barrier_complete(bar, b.x, nloc, nx); b.st[0] = nloc; b.st[1] = nx; }
        const unsigned old = xb_add(&bar[XB_XSUB(b.x)], 1u);
        const unsigned gen = old / nloc;
        if (old + 1u == (gen + 1u) * nloc) {
            __builtin_amdgcn_fence(__ATOMIC_RELEASE, "agent");
            asm volatile("s_waitcnt vmcnt(0)" ::: "memory");
            const unsigned og = xb_add(&bar[XB_TOP], 1u);
            const unsigned tg = og / nx;
            if (og + 1u == (tg + 1u) * nx) xb_add(&bar[XB_TOPGEN], 1u);
            else XB_SPIN(xb_ld(&bar[XB_TOPGEN]) == tg, bar);
            __builtin_amdgcn_fence(__ATOMIC_ACQUIRE, "agent");
            xb_add(&bar[XB_XGEN(b.x)], 1u);
            asm volatile("s_waitcnt vmcnt(0)" ::: "memory");
        } else {
            XB_SPIN(xb_ld(&bar[XB_XGEN(b.x)]) == gen, bar);
            __builtin_amdgcn_fence(__ATOMIC_ACQUIRE, "agent");
            asm volatile("s_waitcnt vmcnt(0)" ::: "memory");
        }
    }
    __syncthreads();
}

__global__ void __launch_bounds__(512, 2) mega(Params p_arg) {
    extern __shared__ __attribute__((aligned(16))) unsigned char lds_raw[];
    LAS unsigned char* lds = (LAS unsigned char*)lds_raw;
    cg::grid_group grid = cg::this_grid();
    volatile LAS unsigned* MISC = (volatile LAS unsigned*)(lds + LDS_BYTES - 64);
    if (threadIdx.x < 16) MISC[threadIdx.x] = 0u;
    __syncthreads();
    XcdBarrier xbar = xcd_barrier_post((unsigned*)(p_arg.ws + WS_CTL), MISC);
    const int ph_lo = p_arg.ph_lo, ph_hi = p_arg.ph_hi;
    for (int ph = ph_lo; ph < ph_hi; ++ph) {
        typedef __attribute__((address_space(4))) const Params* cparams_t;
        cparams_t pp = (cparams_t)__builtin_amdgcn_kernarg_segment_ptr(); asm volatile("" : "+s"(pp));
#if defined(__HIP_DEVICE_COMPILE__)
        const Params p = *pp;
#else
        const Params p = p_arg;
#endif
        bf16_t* HB = (bf16_t*)(p.ws + WS_HB); bf16_t* BIG = (bf16_t*)(p.ws + WS_BIG);
        const float* cosT = (const float*)(p.ws + WS_COS); const float* sinT = (const float*)(p.ws + WS_SIN);
        if (ph == 0) {
#ifndef SK_PREP
            prep_phase(lds, p);
#endif
            norm_phase<false>(p.x, p.ffn1_norm, HB, nullptr);
        } else {
            const int l = (ph - 1) / 12, s = (ph - 1) % 12;
            if (s == 2 || s == 8 || s == 11) continue;
            const unsigned char* wl = p.ws + WS_W + (size_t)l * LW_BYTES;
            bf16_t* HB2 = (bf16_t*)(p.ws + WS_HB2);
            pg8::StaticOrder S;
            if (s == 0 || s == 9) {
                pg8::Gemm g{s == 0 ? HB : HB2, (const bf16_t*)(wl + (s == 0 ? LW_GU1 : LW_GU2)), M, NGU, D}; S.init(M, NGU, GSZ(), BID());
#ifndef SK_G1
                pg8::EpiSwiglu E{BIG}; pg8::gemm_phase(lds, g, S, E);
#endif
            } else if (s == 1 || s == 10 || s == 7) {
                const int inst = 3 * l + (s == 1 ? 0 : (s == 7 ? 1 : 2));
                float* slots = (float*)(p.ws + WS_SLOT) + (size_t)inst * M * 32;
                unsigned* cnt = (unsigned*)(p.ws + WS_CTL) + 4096 + inst * 4096;
                pg8::PanelOrder PO{BID()};
                pg8::Gemm g;
                if (s == 7) g = pg8::Gemm{HB, (const bf16_t*)(wl + LW_WO), M, D, D};
                else g = pg8::Gemm{BIG, (const bf16_t*)(wl + (s == 1 ? LW_D1 : LW_D2)), M, D, FF};
#ifndef SK_G2
                if (s == 10 && l + 1 == DEPTH) {
                    pg8::EpiResNorm<true> E{p.out, p.out, 0.5f, p.final_norm, nullptr, slots, cnt}; pg8::gemm_phase(lds, g, PO, E);
                } else {
                    pg8::EpiResNorm<false> E;
                    if (s == 1) E = pg8::EpiResNorm<false>{l == 0 ? p.x : p.out, p.out, 0.5f, p.mix_norm + l * D, HB, slots, cnt};
                    else if (s == 7) E = pg8::EpiResNorm<false>{p.out, p.out, 1.0f, p.ffn2_norm + l * D, HB2, slots, cnt};
                    else E = pg8::EpiResNorm<false>{p.out, p.out, 0.5f, p.ffn1_norm + (l + 1) * D, HB, slots, cnt};
                    pg8::gemm_phase(lds, g, PO, E);
                }
#endif
            } else if (s == 3) {
                pg8::Gemm g{HB, (const bf16_t*)(wl + LW_IN), M, INC, D}; S.init(M, INC, GSZ(), BID());
#ifndef SK_G3
                pg8::EpiInProj E{BIG, cosT, sinT}; pg8::gemm_phase(lds, g, S, E);
#endif
            } else if (s == 4) {
#ifndef SK_ATT
                attn_phase(lds, p, l);
#endif
#ifndef SK_H1
                hgrn_p1(lds, p, l);
#endif
            } else if (s == 5) {
#ifndef SK_H2
                hgrn_p2(p);
#endif
            } else if (s == 6) {
#ifndef SK_H3
                hgrn_p3(lds, p, l);
#endif
            }
        }
        if (ph + 1 < ph_hi) { if (ph == ph_lo) grid.sync(); else { xbar.bar = (unsigned*)(p.ws + WS_CTL); xcd_barrier(xbar); } }
    }
}

extern "C" void kernel_launch(void* const* d_in, const int* in_sizes, int n_in, void* d_out, int out_size, void* d_ws, size_t ws_size, hipStream_t stream) {
    static int grid = 0;
    if (grid == 0) {
        if (n_in != 20 || out_size != M * D || ws_size < WS_END) { fprintf(stderr, "kernel_launch: unexpected shapes (n_in %d out %d ws %zu need %zu)\n", n_in, out_size, ws_size, (size_t)WS_END); grid = -1; return; }
        int dev = 0, cus = 0, per_cu = 0;
        hipGetDevice(&dev);
        hipDeviceGetAttribute(&cus, hipDeviceAttributeMultiprocessorCount, dev);
        if (hipFuncSetAttribute((const void*)mega, hipFuncAttributeMaxDynamicSharedMemorySize, LDS_BYTES) != hipSuccess) { fprintf(stderr, "kernel_launch: hipFuncSetAttribute failed\n"); grid = -1; return; }
        if (hipOccupancyMaxActiveBlocksPerMultiprocessor(&per_cu, (const void*)mega, 512, LDS_BYTES) != hipSuccess || per_cu < 1) { fprintf(stderr, "kernel_launch: occupancy query says %d\n", per_cu); per_cu = 1; }
        (void)hipGetLastError();
        grid = cus * 1;
        if (grid != 256) { fprintf(stderr, "kernel_launch: this build needs a 256-CU device (got %d)\n", cus); grid = -1; return; }
        fprintf(stderr, "kernel_launch: cus %d per_cu %d grid %d\n", cus, per_cu, grid);
    }
    if (grid < 0) return;
    Params p{};
    p.x = (const float*)d_in[0]; p.ffn1_norm = (const float*)d_in[1]; p.ffn1_wg = (const float*)d_in[2]; p.ffn1_wu = (const float*)d_in[3]; p.ffn1_wd = (const float*)d_in[4];
    p.mix_norm = (const float*)d_in[5]; p.w_in = (const float*)d_in[6]; p.w_out = (const float*)d_in[7];
    p.lq1 = (const float*)d_in[8]; p.lk1 = (const float*)d_in[9]; p.lq2 = (const float*)d_in[10]; p.lk2 = (const float*)d_in[11];
    p.subln = (const float*)d_in[12]; p.hlb = (const float*)d_in[13]; p.gnorm = (const float*)d_in[14];
    p.ffn2_norm = (const float*)d_in[15]; p.ffn2_wg = (const float*)d_in[16]; p.ffn2_wu = (const float*)d_in[17]; p.ffn2_wd = (const float*)d_in[18]; p.final_norm = (const float*)d_in[19];
    p.out = (float*)d_out; p.ws = (unsigned char*)d_ws;
    if (hipMemsetAsync((char*)d_ws + WS_CTL, 0, CTL_BYTES, stream) != hipSuccess) { fprintf(stderr, "kernel_launch: memset failed\n"); return; }
    p.ph_lo = 0; p.ph_hi = NPHASE;
    void* args[] = {&p};
    hipError_t e = hipLaunchCooperativeKernel((const void*)mega, dim3(grid), dim3(512), args, LDS_BYTES, stream);
    if (e != hipSuccess) fprintf(stderr, "kernel_launch: cooperative launch failed: %s (grid %d)\n", hipGetErrorString(e), grid);
}
```
